# Optimizing an MI355X kernel written in HIP

```python
import math
import jax, jax.numpy as jnp
from jax import lax
import numpy as np

D_MODEL = 1024
BATCH = 16
SEQ = 256
DEPTH = 4
DEC_BATCH = 4
DEC_SEQ = 1024
PAST_LEN = 512

GRID_W = 64
HEAD_DIM = 64
A_HEADS = 8
A_KV_HEADS = 2
A_REP = A_HEADS // A_KV_HEADS
A_WIDTH = A_HEADS * HEAD_DIM
A_KV_WIDTH = A_KV_HEADS * HEAD_DIM
Q_BLOCK = 128
ROPE_THETA = 10000.0
B_HEADS = 4
B_DK = 32
B_DV = 64
B_QK_WIDTH = B_HEADS * B_DK
B_WIDTH = B_HEADS * B_DV
GATE_RANK = 16
GATE_TAU = 16.0
C_HEADS = 4
C_DK = 64
C_DV = 64
C_QK_WIDTH = C_HEADS * C_DK
C_WIDTH = C_HEADS * C_DV
CONV_WIDTH = 5
CONV_CH = 2 * C_QK_WIDTH + C_WIDTH
CHUNK = 64
N_DIR = 2
MIX_WIDTH = A_WIDTH + B_WIDTH + C_WIDTH
D_FF = -(-(8 * D_MODEL) // (3 * 256)) * 256
PROJ_SIZES = (A_WIDTH, A_KV_WIDTH, A_KV_WIDTH,
              B_QK_WIDTH, B_QK_WIDTH, B_WIDTH, B_WIDTH, N_DIR * GATE_RANK,
              C_QK_WIDTH, C_QK_WIDTH, C_WIDTH, C_WIDTH, N_DIR * C_HEADS, N_DIR * C_HEADS)
PROJ_WIDTH = sum(PROJ_SIZES)
EPS = 1e-6

kernel_name = 'hybrid_dit_gqa_gla_deltanet_step'


def rms_norm(x, g):
    xf = x.astype(jnp.float32)
    y = xf * lax.rsqrt(jnp.mean(xf * xf, axis=-1, keepdims=True) + EPS)
    return (y * g.astype(jnp.float32)).astype(x.dtype)


def l2_normalize(x):
    return x * lax.rsqrt(jnp.sum(x * x, axis=-1, keepdims=True) + EPS)


def split_cols(z, sizes):
    return jnp.split(z, np.cumsum(sizes)[:-1].tolist(), axis=-1)


def to_heads(z, n):
    b, t, _ = z.shape
    return z.reshape(b, t, n, -1).transpose(0, 2, 1, 3).astype(jnp.float32)


def axial_rope(n_tokens):
    rows = n_tokens // GRID_W
    row = jnp.repeat(jnp.arange(rows, dtype=jnp.float32), GRID_W)
    col = jnp.tile(jnp.arange(GRID_W, dtype=jnp.float32), rows)
    n_freq = HEAD_DIM // 4
    inv_freq = ROPE_THETA ** (-jnp.arange(n_freq, dtype=jnp.float32) / n_freq)
    ang_r = row[:, None] * inv_freq
    ang_c = col[:, None] * inv_freq
    ang = jnp.concatenate([ang_r, ang_r, ang_c, ang_c], axis=-1)
    return jnp.cos(ang), jnp.sin(ang)


def apply_rope(x, cos, sin):
    a1, a2, b1, b2 = jnp.split(x, 4, axis=-1)
    rot = jnp.concatenate([-a2, a1, -b2, b1], axis=-1)
    y = x.astype(jnp.float32) * cos[:, None, :] + rot.astype(jnp.float32) * sin[:, None, :]
    return y.astype(x.dtype)


def attend_blocks(q, k, v):
    bsz, t = q.shape[0], q.shape[1]
    nb = t // Q_BLOCK
    qb = q.reshape(bsz, nb, Q_BLOCK, A_KV_HEADS, A_REP, HEAD_DIM).transpose(1, 0, 2, 3, 4, 5)
    kf = k.astype(jnp.float32)
    vf = v.astype(jnp.float32)
    scale = HEAD_DIM ** -0.5

    def one_block(q_blk):
        s = jnp.einsum('bqgrd,bsgd->bgrqs', q_blk.astype(jnp.float32), kf) * scale
        p = jax.nn.softmax(s, axis=-1)
        return jnp.einsum('bgrqs,bsgd->bqgrd', p, vf).astype(q.dtype)

    o = lax.map(one_block, qb)
    return o.transpose(1, 0, 2, 3, 4, 5).reshape(bsz, t, A_WIDTH)


def to_chunks(a):
    n = a.shape[2] // CHUNK
    return jnp.moveaxis(a.reshape(a.shape[:2] + (n, CHUNK) + a.shape[3:]), 2, 0)


def from_chunks(o):
    o = jnp.moveaxis(o, 0, 2)
    return o.reshape(o.shape[:2] + (-1,) + o.shape[4:])


def gla_scan(q, k, v, g, s0):
    causal = jnp.tril(jnp.ones((CHUNK, CHUNK), dtype=bool))[:, :, None]

    def body(s, inp):
        qc, kc, vc, gc = inp
        b = jnp.cumsum(gc, axis=2)
        diff = b[:, :, :, None, :] - b[:, :, None, :, :]
        decay = jnp.exp(jnp.where(causal, diff, -jnp.inf))
        att = jnp.einsum('bhtk,bhsk,bhtsk->bhts', qc, kc, decay)
        o = (jnp.einsum('bhtk,bhkv->bhtv', qc * jnp.exp(b), s)
             + jnp.einsum('bhts,bhsv->bhtv', att, vc))
        bl = b[:, :, -1:, :]
        s = (jnp.exp(bl)[:, :, 0, :, None] * s
             + jnp.einsum('bhsk,bhsv->bhkv', kc * jnp.exp(bl - b), vc))
        return s, o

    s, o = lax.scan(body, s0, (to_chunks(q), to_chunks(k), to_chunks(v), to_chunks(g)))
    return from_chunks(o), s


def delta_scan(q, k, v, beta, g, s0):
    incl = jnp.tril(jnp.ones((CHUNK, CHUNK), dtype=bool))
    strict = jnp.tril(jnp.ones((CHUNK, CHUNK), dtype=bool), -1)
    eye = jnp.eye(CHUNK, dtype=jnp.float32)
    dv = v.shape[-1]

    def body(s, inp):
        qc, kc, vc, bc, gc = inp
        gam = jnp.cumsum(gc, axis=-1)
        diff = gam[..., :, None] - gam[..., None, :]
        dec = jnp.exp(jnp.where(incl, diff, -jnp.inf))
        kb = kc * bc[..., None]
        m = jnp.where(strict, jnp.einsum('bhtk,bhsk->bhts', kb, kc) * dec, 0.0)
        rhs = jnp.concatenate([vc * bc[..., None], kb * jnp.exp(gam)[..., None]], axis=-1)
        sol = lax.linalg.triangular_solve(eye + m, rhs, left_side=True, lower=True,
                                          unit_diagonal=True)
        u, w = sol[..., :dv], sol[..., dv:]
        v_new = u - jnp.einsum('bhtk,bhkv->bhtv', w, s)
        att = jnp.einsum('bhtk,bhsk->bhts', qc, kc) * dec
        o = (jnp.einsum('bhtk,bhkv->bhtv', qc * jnp.exp(gam)[..., None], s)
             + jnp.einsum('bhts,bhsv->bhtv', att, v_new))
        gl = gam[..., -1:]
        s = (jnp.exp(gl)[..., None] * s
             + jnp.einsum('bhsk,bhsv->bhkv', kc * jnp.exp(gl - gam)[..., None], v_new))
        return s, o

    s, o = lax.scan(body, s0, (to_chunks(q), to_chunks(k), to_chunks(v),
                              to_chunks(beta), to_chunks(g)))
    return from_chunks(o), s


def run_direction(scan_fn, arrays, s0, reverse):
    if reverse:
        arrays = tuple(jnp.flip(a, axis=2) for a in arrays)
    o, s = scan_fn(*arrays, s0)
    if reverse:
        o = jnp.flip(o, axis=2)
    return o, s


def short_conv(z, w):
    y = lax.conv_general_dilated(
        z, w[:, None, :].astype(z.dtype), window_strides=(1,),
        padding=((CONV_WIDTH // 2, CONV_WIDTH // 2),),
        dimension_numbers=('NWC', 'WIO', 'NWC'), feature_group_count=z.shape[-1])
    return jax.nn.silu(y)


def mixer(h, w_in, qk_g, w_gg, b_gg, gla_g, conv_w, a_log, dt_bias, delta_g, w_out,
          ctx_kv, s0_gla, s0_delta, rope):
    f32 = jnp.float32
    bsz, t, _ = h.shape
    (qa, ka, va, qb, kb, vb, rb, gcode, qc, kc, vc, gc, bc, ac) = split_cols(h @ w_in, PROJ_SIZES)

    qa = rms_norm(qa.reshape(bsz, t, A_HEADS, HEAD_DIM), qk_g[0])
    ka = rms_norm(ka.reshape(bsz, t, A_KV_HEADS, HEAD_DIM), qk_g[1])
    va = va.reshape(bsz, t, A_KV_HEADS, HEAD_DIM)
    if ctx_kv is None:
        oa = attend_blocks(qa, ka, va)
    else:
        cos, sin = rope
        k_all = jnp.concatenate([ctx_kv[0].astype(ka.dtype), apply_rope(ka, cos, sin)], axis=1)
        v_all = jnp.concatenate([ctx_kv[1].astype(va.dtype), va], axis=1)
        oa = attend_blocks(apply_rope(qa, cos, sin), k_all, v_all)

    qb = to_heads(qb, B_HEADS) * B_DK ** -0.5
    kb = to_heads(kb, B_HEADS)
    vb = to_heads(vb, B_HEADS)
    glog = jax.nn.log_sigmoid(
        jnp.einsum('btdr,drk->btdk', gcode.reshape(bsz, t, N_DIR, GATE_RANK).astype(f32),
                   w_gg.astype(f32)) + b_gg.astype(f32)) / GATE_TAU
    ob = 0.0
    s_gla = []
    for d in range(N_DIR):
        o_d, s_d = run_direction(gla_scan, (qb, kb, vb, to_heads(glog[:, :, d], B_HEADS)),
                                 s0_gla[:, d], d == 1)
        ob = ob + o_d
        s_gla.append(s_d)
    ob = rms_norm(ob.transpose(0, 2, 1, 3), gla_g).reshape(bsz, t, B_WIDTH) * jax.nn.silu(rb.astype(f32))

    qkv = short_conv(jnp.concatenate([qc, kc, vc], axis=-1), conv_w)
    qc, kc, vc = split_cols(qkv, (C_QK_WIDTH, C_QK_WIDTH, C_WIDTH))
    qc = l2_normalize(to_heads(qc, C_HEADS)) * C_DK ** -0.5
    kc = l2_normalize(to_heads(kc, C_HEADS))
    vc = to_heads(vc, C_HEADS)
    beta = jax.nn.sigmoid(bc.reshape(bsz, t, N_DIR, C_HEADS).astype(f32))
    glog_c = -jnp.exp(a_log.astype(f32)) * jax.nn.softplus(
        ac.reshape(bsz, t, N_DIR, C_HEADS).astype(f32) + dt_bias.astype(f32))
    oc = 0.0
    s_delta = []
    for d in range(N_DIR):
        o_d, s_d = run_direction(delta_scan,
                                 (qc, kc, vc, beta[:, :, d].transpose(0, 2, 1),
                                  glog_c[:, :, d].transpose(0, 2, 1)),
                                 s0_delta[:, d], d == 1)
        oc = oc + o_d
        s_delta.append(s_d)
    oc = rms_norm(oc.transpose(0, 2, 1, 3), delta_g).reshape(bsz, t, C_WIDTH) * jax.nn.silu(gc.astype(f32))

    out = jnp.concatenate([oa, ob.astype(h.dtype), oc.astype(h.dtype)], axis=-1) @ w_out
    return out, ka, va, jnp.stack(s_gla, axis=1), jnp.stack(s_delta, axis=1)


def block(x, mod, lw, ctx_kv, s0_gla, s0_delta, rope):
    (norm_g, w_in, qk_g, w_gg, b_gg, gla_g, conv_w, a_log, dt_bias, delta_g, w_out,
     w_gate, w_up, w_down) = lw
    shift_m, scale_m, gate_m, shift_f, scale_f, gate_f = jnp.split(mod, 6, axis=-1)
    h = rms_norm(x, norm_g[0]) * (1 + scale_m) + shift_m
    mix, k_l, v_l, s_gla, s_delta = mixer(h, w_in, qk_g, w_gg, b_gg, gla_g, conv_w, a_log,
                                          dt_bias, delta_g, w_out, ctx_kv, s0_gla, s0_delta, rope)
    x = x + gate_m * rms_norm(mix, norm_g[1])
    h = rms_norm(x, norm_g[2]) * (1 + scale_f) + shift_f
    f = (jax.nn.silu(h @ w_gate) * (h @ w_up)) @ w_down
    x = x + gate_f * rms_norm(f, norm_g[3])
    return x, k_l, v_l, s_gla, s_delta


def setup_inputs(seed: int = 0) -> dict:
    key = jax.random.key(seed)
    ks = jax.random.split(key, 26)
    f32 = jnp.float32

    def nrm(k, shape, s):
        return jax.random.normal(k, shape, f32) * s

    dt = jnp.exp(jax.random.uniform(ks[18], (DEPTH, N_DIR, C_HEADS), f32,
                                    math.log(1e-3), math.log(1e-1)))
    return {
        'x_prompt': nrm(ks[0], (BATCH, SEQ, D_MODEL), 1.0),
        'x_sample': nrm(ks[1], (DEC_BATCH, DEC_SEQ, D_MODEL), 1.0),
        'cache_k': nrm(ks[3], (DEC_BATCH, DEPTH, PAST_LEN, A_KV_HEADS, HEAD_DIM), 1.0),
        'cache_v': nrm(ks[4], (DEC_BATCH, DEPTH, PAST_LEN, A_KV_HEADS, HEAD_DIM), 1.0),
        'state_gla': nrm(ks[5], (DEC_BATCH, DEPTH, N_DIR, B_HEADS, B_DK, B_DV), 0.3),
        'state_delta': nrm(ks[6], (DEC_BATCH, DEPTH, N_DIR, C_HEADS, C_DK, C_DV), 0.3),
        'c': nrm(ks[2], (DEC_BATCH, D_MODEL), 1.0),
        'c_ctx': nrm(ks[7], (D_MODEL,), 1.0),
        'w_mod': nrm(ks[8], (DEPTH, D_MODEL, 6 * D_MODEL), D_MODEL ** -0.5),
        'b_mod': nrm(ks[9], (DEPTH, 6 * D_MODEL), 0.02),
        'norm_gains': 1.0 + nrm(ks[10], (DEPTH, 4, D_MODEL), 0.05),
        'w_in': nrm(ks[11], (DEPTH, D_MODEL, PROJ_WIDTH), D_MODEL ** -0.5),
        'qk_gain': 1.0 + nrm(ks[12], (DEPTH, 2, HEAD_DIM), 0.05),
        'w_gla_gate': nrm(ks[13], (DEPTH, N_DIR, GATE_RANK, B_QK_WIDTH), GATE_RANK ** -0.5),
        'b_gla_gate': nrm(ks[14], (DEPTH, N_DIR, B_QK_WIDTH), 0.1),
        'gla_norm': 1.0 + nrm(ks[15], (DEPTH, B_DV), 0.05),
        'conv_w': nrm(ks[16], (DEPTH, CONV_WIDTH, CONV_CH), CONV_WIDTH ** -0.5),
        'a_log': jnp.log(jax.random.uniform(ks[17], (DEPTH, N_DIR, C_HEADS), f32, 1.0, 16.0)),
        'dt_bias': dt + jnp.log(-jnp.expm1(-dt)),
        'delta_norm': 1.0 + nrm(ks[19], (DEPTH, C_DV), 0.05),
        'w_out': nrm(ks[20], (DEPTH, MIX_WIDTH, D_MODEL), MIX_WIDTH ** -0.5),
        'w_gate': nrm(ks[21], (DEPTH, D_MODEL, D_FF), D_MODEL ** -0.5),
        'w_up': nrm(ks[22], (DEPTH, D_MODEL, D_FF), D_MODEL ** -0.5),
        'w_down': nrm(ks[23], (DEPTH, D_FF, D_MODEL), D_FF ** -0.5),
    }


def reference(x_prompt, x_sample, cache_k, cache_v, state_gla, state_delta, c, c_ctx,
              w_mod, b_mod, norm_gains, w_in, qk_gain, w_gla_gate, b_gla_gate, gla_norm,
              conv_w, a_log, dt_bias, delta_norm, w_out, w_gate, w_up, w_down):
    f32 = jnp.float32
    rope = axial_rope(x_sample.shape[1])
    n_ctx_req = x_prompt.shape[0]
    zero_gla = jnp.zeros((n_ctx_req, N_DIR, B_HEADS, B_DK, B_DV), f32)
    zero_delta = jnp.zeros((n_ctx_req, N_DIR, C_HEADS, C_DK, C_DV), f32)
    xp, xs = x_prompt, x_sample
    new_k, new_v, new_gla, new_delta = [], [], [], []
    for l in range(DEPTH):
        lw = (norm_gains[l], w_in[l], qk_gain[l], w_gla_gate[l], b_gla_gate[l], gla_norm[l],
              conv_w[l], a_log[l], dt_bias[l], delta_norm[l], w_out[l],
              w_gate[l], w_up[l], w_down[l])
        mod_ctx = (jax.nn.silu(c_ctx) @ w_mod[l] + b_mod[l])[None, None, :]
        xp, k_l, v_l, sg_l, sd_l = block(xp, mod_ctx, lw, None, zero_gla, zero_delta, None)
        new_k.append(k_l)
        new_v.append(v_l)
        new_gla.append(sg_l)
        new_delta.append(sd_l)
        mod_lat = (jax.nn.silu(c) @ w_mod[l] + b_mod[l])[:, None, :]
        xs = block(xs, mod_lat, lw, (cache_k[:, l], cache_v[:, l]),
                   state_gla[:, l].astype(f32), state_delta[:, l].astype(f32), rope)[0]
    out_dtype = x_prompt.dtype
    new_cache_k = jnp.stack(new_k, axis=1)
    new_cache_v = jnp.stack(new_v, axis=1)
    new_state_gla = jnp.stack(new_gla, axis=1).astype(out_dtype)
    new_state_delta = jnp.stack(new_delta, axis=1).astype(out_dtype)
    return (xp, xs, new_cache_k, new_cache_v, new_state_gla, new_state_delta)
```

```cpp
#include <hip/hip_runtime.h>
#include <cstdio>

typedef __attribute__((ext_vector_type(8))) short bf16x8;
typedef __attribute__((ext_vector_type(4))) float f32x4;
typedef __attribute__((ext_vector_type(16))) float f32x16;
typedef unsigned short u16;

#define NT 8192
#define PW 2608
#define DFF 2816
#define EPSF 1e-6f
#define LDS_BYTES 73728

enum { I_XP = 0, I_XS, I_CK, I_CV, I_SG, I_SD, I_C, I_CCTX, I_WMOD, I_BMOD, I_NG, I_WIN, I_QKG, I_WGG, I_BGG,
       I_GLAN, I_CONVW, I_ALOG, I_DTB, I_DELN, I_WOUT, I_WGATE, I_WUP, I_WDOWN };

constexpr size_t O_NCK = 8388608, O_NCV = 10485760, O_NSG = 12582912, O_NSD = 13631488;

constexpr size_t OFF_MODV = 0;
constexpr size_t OFF_H = 524288;
constexpr size_t OFF_MIXIN = OFF_H + (size_t)NT * 1024 * 2;
constexpr size_t OFF_Z = OFF_MIXIN + (size_t)NT * 1024 * 2;
constexpr size_t OFF_QB = OFF_Z + (size_t)NT * PW * 4;
constexpr size_t OFF_KB = OFF_QB + (size_t)NT * 512 * 2;
constexpr size_t OFF_VB = OFF_KB + (size_t)NT * 128 * 2;
constexpr size_t OFF_CB = OFF_VB + (size_t)NT * 128 * 2;
constexpr size_t OFF_GLOG = OFF_CB + (size_t)NT * 768 * 4;
constexpr size_t OFF_BETA = OFF_GLOG + (size_t)NT * 256 * 4;
constexpr size_t OFF_GDEC = OFF_BETA + (size_t)NT * 8 * 4;
constexpr size_t OFF_UW = OFF_GDEC + (size_t)NT * 8 * 4;
constexpr size_t OFF_SDC = OFF_UW + (size_t)1024 * 8192 * 4;
constexpr size_t OFF_SGC = OFF_SDC + (size_t)1024 * 4096 * 4;
constexpr size_t OFF_MIX = OFF_SGC + (size_t)1024 * 2048 * 4;
constexpr size_t OFF_BAR = OFF_MIX + (size_t)NT * 1024 * 4;
constexpr size_t WS_END = OFF_BAR + 16384;

struct Params {
  const float* in[24];
  float* out;
  char* ws;
};

__device__ __forceinline__ unsigned f2bf(float f) { unsigned u = __float_as_uint(f); return (u + 0x7fffu + ((u >> 16) & 1u)) >> 16; }
__device__ __forceinline__ unsigned pk2(float lo, float hi) { return f2bf(lo) | (f2bf(hi) << 16); }
__device__ __forceinline__ float wave_sum(float v) {
#pragma unroll
  for (int o = 32; o; o >>= 1) v += __shfl_xor(v, o);
  return v;
}
__device__ __forceinline__ float siluf(float x) { return x / (1.f + __expf(-x)); }
__device__ __forceinline__ float sigmf(float x) { return 1.f / (1.f + __expf(-x)); }
__device__ __forceinline__ float softplusf(float x) { return x > 20.f ? x : log1pf(__expf(x)); }
__device__ __forceinline__ int rmap(int dir, int i) { return dir ? 63 - i : i; }
__device__ __forceinline__ float wave_cumsum(float v, int lane) {
#pragma unroll
  for (int o = 1; o < 64; o <<= 1) { float t = __shfl_up(v, o); if (lane >= o) v += t; }
  return v;
}

__device__ __forceinline__ int ltid() { int v = threadIdx.x; asm volatile("" : "+v"(v)); return v; }
__device__ __forceinline__ int lbid() { int v = blockIdx.x; asm volatile("" : "+s"(v)); return v; }

__device__ __forceinline__ void phase_mod(const Params& p, char* smem) {
  float* sc = (float*)smem;
  float* red = sc + 5 * 1024;
  const int tid = ltid();
  for (int i = tid; i < 5 * 1024; i += 256) {
    int m = i >> 10, k = i & 1023;
    float c = (m == 0) ? p.in[I_CCTX][k] : p.in[I_C][(m - 1) * 1024 + k];
    sc[i] = siluf(c);
  }
  __syncthreads();
  float* modv = (float*)(p.ws + OFF_MODV);
  const int col = tid & 63, kg = tid >> 6;
  for (int t = lbid(); t < 384; t += gridDim.x) {
    const int l = t / 96, n0 = (t % 96) * 64;
    const float* w = p.in[I_WMOD] + (size_t)l * 1024 * 6144 + (size_t)(kg * 256) * 6144 + n0 + col;
    float a0 = 0.f, a1 = 0.f, a2 = 0.f, a3 = 0.f, a4 = 0.f;
#pragma unroll 8
    for (int k = 0; k < 256; ++k) {
      float wv = w[(size_t)k * 6144];
      int kk = kg * 256 + k;
      a0 += sc[kk] * wv; a1 += sc[1024 + kk] * wv; a2 += sc[2048 + kk] * wv; a3 += sc[3072 + kk] * wv; a4 += sc[4096 + kk] * wv;
    }
    red[(kg * 5 + 0) * 64 + col] = a0; red[(kg * 5 + 1) * 64 + col] = a1; red[(kg * 5 + 2) * 64 + col] = a2;
    red[(kg * 5 + 3) * 64 + col] = a3; red[(kg * 5 + 4) * 64 + col] = a4;
    __syncthreads();
    if (tid < 64) {
      float bb = p.in[I_BMOD][l * 6144 + n0 + col];
#pragma unroll
      for (int m = 0; m < 5; ++m) {
        float s = red[(0 * 5 + m) * 64 + col] + red[(1 * 5 + m) * 64 + col] + red[(2 * 5 + m) * 64 + col] + red[(3 * 5 + m) * 64 + col];
        modv[(size_t)(l * 5 + m) * 6144 + n0 + col] = s + bb;
      }
    }
    __syncthreads();
  }
}

__device__ __forceinline__ void phase_row(const Params& p, int l, int mode) {
  const int lane = ltid() & 63, wave = ltid() >> 6;
  float* X = p.out;
  const float* MIX = (const float*)(p.ws + OFF_MIX);
  u16* H = (u16*)(p.ws + OFF_H);
  const float* modv = (const float*)(p.ws + OFF_MODV);
  const float* ng = p.in[I_NG];
  const bool first = (mode == 0 && l == 0);
  for (int row = lbid() * 4 + wave; row < NT; row += gridDim.x * 4) {
    const int m = row < 4096 ? 0 : 1 + ((row - 4096) >> 10);
    const float* xsrc = first ? (row < 4096 ? p.in[I_XP] + (size_t)row * 1024 : p.in[I_XS] + (size_t)(row - 4096) * 1024)
                              : X + (size_t)row * 1024;
    float x[16];
#pragma unroll
    for (int i = 0; i < 4; ++i) {
      float4 v = *(const float4*)(xsrc + i * 256 + lane * 4);
      x[i * 4 + 0] = v.x; x[i * 4 + 1] = v.y; x[i * 4 + 2] = v.z; x[i * 4 + 3] = v.w;
    }
    if (!first) {
      const float* y = MIX + (size_t)row * 1024;
      const float* ga; const float* gate;
      if (mode == 0) { ga = ng + ((l - 1) * 4 + 3) * 1024; gate = modv + (size_t)((l - 1) * 5 + m) * 6144 + 5 * 1024; }
      else { ga = ng + (l * 4 + 1) * 1024; gate = modv + (size_t)(l * 5 + m) * 6144 + 2 * 1024; }
      float yv[16]; float ss = 0.f;
#pragma unroll
      for (int i = 0; i < 4; ++i) {
        float4 v = *(const float4*)(y + i * 256 + lane * 4);
        yv[i * 4 + 0] = v.x; yv[i * 4 + 1] = v.y; yv[i * 4 + 2] = v.z; yv[i * 4 + 3] = v.w;
        ss += v.x * v.x + v.y * v.y + v.z * v.z + v.w * v.w;
      }
      ss = wave_sum(ss);
      const float rstd = rsqrtf(ss * (1.f / 1024.f) + EPSF);
#pragma unroll
      for (int i = 0; i < 4; ++i) {
        float4 g4 = *(const float4*)(ga + i * 256 + lane * 4);
        float4 t4 = *(const float4*)(gate + i * 256 + lane * 4);
        x[i * 4 + 0] += t4.x * (yv[i * 4 + 0] * rstd * g4.x);
        x[i * 4 + 1] += t4.y * (yv[i * 4 + 1] * rstd * g4.y);
        x[i * 4 + 2] += t4.z * (yv[i * 4 + 2] * rstd * g4.z);
        x[i * 4 + 3] += t4.w * (yv[i * 4 + 3] * rstd * g4.w);
      }
    }
#pragma unroll
    for (int i = 0; i < 4; ++i) {
      float4 v; v.x = x[i * 4 + 0]; v.y = x[i * 4 + 1]; v.z = x[i * 4 + 2]; v.w = x[i * 4 + 3];
      *(float4*)(X + (size_t)row * 1024 + i * 256 + lane * 4) = v;
    }
    if (mode == 1 || l < 4) {
      float ss = 0.f;
#pragma unroll
      for (int i = 0; i < 16; ++i) ss += x[i] * x[i];
      ss = wave_sum(ss);
      const float rstd = rsqrtf(ss * (1.f / 1024.f) + EPSF);
      const float* gb = ng + (l * 4 + (mode == 0 ? 0 : 2)) * 1024;
      const float* scale = modv + (size_t)(l * 5 + m) * 6144 + (mode == 0 ? 1 : 4) * 1024;
      const float* shift = modv + (size_t)(l * 5 + m) * 6144 + (mode == 0 ? 0 : 3) * 1024;
#pragma unroll
      for (int i = 0; i < 4; ++i) {
        float4 g4 = *(const float4*)(gb + i * 256 + lane * 4);
        float4 s4 = *(const float4*)(scale + i * 256 + lane * 4);
        float4 h4 = *(const float4*)(shift + i * 256 + lane * 4);
        float h0 = x[i * 4 + 0] * rstd * g4.x * (1.f + s4.x) + h4.x;
        float h1 = x[i * 4 + 1] * rstd * g4.y * (1.f + s4.y) + h4.y;
        float h2 = x[i * 4 + 2] * rstd * g4.z * (1.f + s4.z) + h4.z;
        float h3 = x[i * 4 + 3] * rstd * g4.w * (1.f + s4.w) + h4.w;
        uint2 o; o.x = pk2(h0, h1); o.y = pk2(h2, h3);
        *(uint2*)(H + (size_t)row * 1024 + i * 256 + lane * 4) = o;
      }
    }
  }
}

template <int EPI>
__device__ __forceinline__ void phase_gemm(const u16* __restrict__ A, int K, const float* __restrict__ W0, const float* __restrict__ W1, int N,
                           void* outp, char* smem) {
  u16* sA = (u16*)smem;
  u16* sB = sA + 2 * 128 * 40;
  const int tid = ltid(), lane = tid & 63, wave = tid >> 6, r = lane & 31, h = lane >> 5;
  const int wm = wave >> 1, wn = wave & 1;
  const int ntn = (EPI == 0) ? (N + 127) / 128 : N / 64;
  const int ntiles = 64 * ntn;
  const int nk = K / 32;
  const int nl = tid & 127, kg = tid >> 7;
  for (int t = lbid(); t < ntiles; t += gridDim.x) {
    const int tm = t & 63, tn = t >> 6;
    const int m0 = tm * 128;
    const float* bp;
    if (EPI == 0) { int col = tn * 128 + nl; if (col > N - 1) col = N - 1; bp = W0 + col; }
    else { bp = (nl < 64) ? (W0 + tn * 64 + nl) : (W1 + tn * 64 + (nl - 64)); }
    bp += (size_t)(kg * 16) * N;
    const u16* ap0 = A + (size_t)(m0 + (tid >> 2)) * K + (tid & 3) * 8;
    const u16* ap1 = ap0 + (size_t)64 * K;
    f32x16 acc[2][2];
#pragma unroll
    for (int i = 0; i < 2; ++i)
#pragma unroll
      for (int j = 0; j < 2; ++j)
#pragma unroll
        for (int e = 0; e < 16; ++e) acc[i][j][e] = 0.f;
    uint4 ra0, ra1; float rb[16];
    ra0 = *(const uint4*)ap0; ra1 = *(const uint4*)ap1;
#pragma unroll
    for (int j = 0; j < 16; ++j) rb[j] = bp[(size_t)j * N];
    {
      u16* dA = sA; u16* dB = sB;
      *(uint4*)(dA + (tid >> 2) * 40 + (tid & 3) * 8) = ra0;
      *(uint4*)(dA + (64 + (tid >> 2)) * 40 + (tid & 3) * 8) = ra1;
      uint4 q0, q1;
      q0.x = pk2(rb[0], rb[1]); q0.y = pk2(rb[2], rb[3]); q0.z = pk2(rb[4], rb[5]); q0.w = pk2(rb[6], rb[7]);
      q1.x = pk2(rb[8], rb[9]); q1.y = pk2(rb[10], rb[11]); q1.z = pk2(rb[12], rb[13]); q1.w = pk2(rb[14], rb[15]);
      *(uint4*)(dB + nl * 40 + kg * 16) = q0;
      *(uint4*)(dB + nl * 40 + kg * 16 + 8) = q1;
    }
    __syncthreads();
    for (int kt = 0; kt < nk; ++kt) {
      const bool more = (kt + 1 < nk);
      if (more) {
        ra0 = *(const uint4*)(ap0 + (kt + 1) * 32); ra1 = *(const uint4*)(ap1 + (kt + 1) * 32);
        const float* bq = bp + (size_t)(kt + 1) * 32 * N;
#pragma unroll
        for (int j = 0; j < 16; ++j) rb[j] = bq[(size_t)j * N];
      }
      const u16* cA = sA + (kt & 1) * 128 * 40;
      const u16* cB = sB + (kt & 1) * 128 * 40;
#pragma unroll
      for (int ks = 0; ks < 2; ++ks) {
        bf16x8 af[2], bfr[2];
#pragma unroll
        for (int i = 0; i < 2; ++i) af[i] = *(const bf16x8*)(cA + (wm * 64 + i * 32 + r) * 40 + ks * 16 + h * 8);
#pragma unroll
        for (int j = 0; j < 2; ++j) bfr[j] = *(const bf16x8*)(cB + (j * 64 + wn * 32 + r) * 40 + ks * 16 + h * 8);
#pragma unroll
        for (int i = 0; i < 2; ++i)
#pragma unroll
          for (int j = 0; j < 2; ++j) acc[i][j] = __builtin_amdgcn_mfma_f32_32x32x16_bf16(af[i], bfr[j], acc[i][j], 0, 0, 0);
      }
      if (more) {
        u16* dA = sA + ((kt + 1) & 1) * 128 * 40; u16* dB = sB + ((kt + 1) & 1) * 128 * 40;
        *(uint4*)(dA + (tid >> 2) * 40 + (tid & 3) * 8) = ra0;
        *(uint4*)(dA + (64 + (tid >> 2)) * 40 + (tid & 3) * 8) = ra1;
        uint4 q0, q1;
        q0.x = pk2(rb[0], rb[1]); q0.y = pk2(rb[2], rb[3]); q0.z = pk2(rb[4], rb[5]); q0.w = pk2(rb[6], rb[7]);
        q1.x = pk2(rb[8], rb[9]); q1.y = pk2(rb[10], rb[11]); q1.z = pk2(rb[12], rb[13]); q1.w = pk2(rb[14], rb[15]);
        *(uint4*)(dB + nl * 40 + kg * 16) = q0;
        *(uint4*)(dB + nl * 40 + kg * 16 + 8) = q1;
      }
      __syncthreads();
    }
    if (EPI == 0) {
      float* C = (float*)outp;
#pragma unroll
      for (int i = 0; i < 2; ++i)
#pragma unroll
        for (int j = 0; j < 2; ++j) {
          const int col = tn * 128 + j * 64 + wn * 32 + r;
          if (col < N) {
#pragma unroll
            for (int e = 0; e < 16; ++e) {
              const int row = m0 + wm * 64 + i * 32 + (e & 3) + 8 * (e >> 2) + 4 * h;
              C[(size_t)row * N + col] = acc[i][j][e];
            }
          }
        }
    } else {
      u16* C = (u16*)outp;
#pragma unroll
      for (int i = 0; i < 2; ++i) {
        const int col = tn * 64 + wn * 32 + r;
#pragma unroll
        for (int e = 0; e < 16; ++e) {
          const int row = m0 + wm * 64 + i * 32 + (e & 3) + 8 * (e >> 2) + 4 * h;
          const float g = acc[i][0][e], u = acc[i][1][e];
          C[(size_t)row * N + col] = (u16)f2bf(siluf(g) * u);
        }
      }
    }
  }
}

__device__ __forceinline__ void phase_prep(const Params& p, int l) {
  const int lane = ltid() & 63, wave = ltid() >> 6;
  const float* Z = (const float*)(p.ws + OFF_Z);
  u16* QB = (u16*)(p.ws + OFF_QB); u16* KB = (u16*)(p.ws + OFF_KB); u16* VB = (u16*)(p.ws + OFF_VB);
  float* CB = (float*)(p.ws + OFF_CB); float* GLOG = (float*)(p.ws + OFF_GLOG);
  float* BETA = (float*)(p.ws + OFF_BETA); float* GDEC = (float*)(p.ws + OFF_GDEC);
  const float* qkg = p.in[I_QKG] + l * 128;
  const float* convw = p.in[I_CONVW] + l * 5 * 768;
  const float* wgg = p.in[I_WGG] + l * 2 * 16 * 128;
  const float* bgg = p.in[I_BGG] + l * 256;
  const float LOG2_THETA_16 = 13.287712379549449f / 16.f;
  for (int t = lbid() * 4 + wave; t < NT; t += gridDim.x * 4) {
    const bool lat = t >= 4096;
    const int b = lat ? (t - 4096) >> 10 : t >> 8;
    const int s = lat ? (t - 4096) & 1023 : t & 255;
    const int slen = lat ? 1024 : 256;
    const float* zr = Z + (size_t)t * PW;
    const float prow = (float)(s >> 6), pcol = (float)(s & 63);
    {
      const int head = lane >> 3, sub = lane & 7;
      float v[4][2]; float ss = 0.f;
#pragma unroll
      for (int q = 0; q < 4; ++q) {
        float2 f = *(const float2*)(zr + head * 64 + q * 16 + sub * 2);
        v[q][0] = f.x; v[q][1] = f.y; ss += f.x * f.x + f.y * f.y;
      }
      ss += __shfl_xor(ss, 1); ss += __shfl_xor(ss, 2); ss += __shfl_xor(ss, 4);
      const float rstd = rsqrtf(ss * (1.f / 64.f) + EPSF);
#pragma unroll
      for (int q = 0; q < 4; ++q)
#pragma unroll
        for (int i = 0; i < 2; ++i) v[q][i] *= rstd * qkg[q * 16 + sub * 2 + i];
      if (lat) {
#pragma unroll
        for (int i = 0; i < 2; ++i) {
          const float inv = exp2f(-(float)(sub * 2 + i) * LOG2_THETA_16);
          const float ar = prow * inv, ac = pcol * inv;
          const float cr = __cosf(ar), sr = __sinf(ar), cc = __cosf(ac), sn = __sinf(ac);
          const float a1 = v[0][i], a2 = v[1][i], b1 = v[2][i], b2 = v[3][i];
          v[0][i] = a1 * cr - a2 * sr; v[1][i] = a2 * cr + a1 * sr;
          v[2][i] = b1 * cc - b2 * sn; v[3][i] = b2 * cc + b1 * sn;
        }
      }
#pragma unroll
      for (int q = 0; q < 4; ++q) *(unsigned*)(QB + (size_t)t * 512 + head * 64 + q * 16 + sub * 2) = pk2(v[q][0], v[q][1]);
    }
    {
      const int g = lane >> 5, j = lane & 31;
      const int d0 = j + (j >= 16 ? 16 : 0), d1 = d0 + 16;
      float v0 = zr[512 + g * 64 + d0], v1 = zr[512 + g * 64 + d1];
      float ss = v0 * v0 + v1 * v1;
      ss += __shfl_xor(ss, 1); ss += __shfl_xor(ss, 2); ss += __shfl_xor(ss, 4); ss += __shfl_xor(ss, 8); ss += __shfl_xor(ss, 16);
      const float rstd = rsqrtf(ss * (1.f / 64.f) + EPSF);
      v0 *= rstd * qkg[64 + d0]; v1 *= rstd * qkg[64 + d1];
      if (!lat) {
        float* nk = p.out + O_NCK + ((size_t)(b * 4 + l) * 256 + s) * 128 + g * 64;
        nk[d0] = v0; nk[d1] = v1;
      } else {
        const float inv = exp2f(-(float)(j & 15) * LOG2_THETA_16);
        const float ang = (j < 16 ? prow : pcol) * inv;
        const float c = __cosf(ang), sn = __sinf(ang);
        const float y0 = v0 * c - v1 * sn, y1 = v1 * c + v0 * sn;
        v0 = y0; v1 = y1;
      }
      KB[(size_t)t * 128 + g * 64 + d0] = (u16)f2bf(v0);
      KB[(size_t)t * 128 + g * 64 + d1] = (u16)f2bf(v1);
    }
    {
      float2 f = *(const float2*)(zr + 640 + lane * 2);
      if (!lat) *(float2*)(p.out + O_NCV + ((size_t)(b * 4 + l) * 256 + s) * 128 + lane * 2) = f;
      *(unsigned*)(VB + (size_t)t * 128 + lane * 2) = pk2(f.x, f.y);
    }
    {
#pragma unroll 1
      for (int i = 0; i < 12; ++i) {
        const int c = i * 64 + lane;
        float acc = 0.f;
#pragma unroll
        for (int j = 0; j < 5; ++j) {
          const int sj = s + j - 2;
          if (sj >= 0 && sj < slen) acc += Z[(size_t)(t + j - 2) * PW + 1568 + c] * convw[j * 768 + c];
        }
        float y = siluf(acc);
        if (i < 8) {
          const float ss = wave_sum(y * y);
          y *= rsqrtf(ss + EPSF) * (i < 4 ? 0.125f : 1.f);
        }
        CB[(size_t)t * 768 + c] = y;
      }
    }
    {
#pragma unroll 1
      for (int i = 0; i < 4; ++i) {
        const int o = i * 64 + lane, dir = o >> 7, k = o & 127;
        float acc = bgg[dir * 128 + k];
#pragma unroll
        for (int rr = 0; rr < 16; ++rr) acc += zr[1536 + dir * 16 + rr] * wgg[(dir * 16 + rr) * 128 + k];
        GLOG[(size_t)t * 256 + o] = -softplusf(-acc) * (1.f / 16.f);
      }
    }
    if (lane < 8) BETA[t * 8 + lane] = sigmf(zr[2592 + lane]);
    else if (lane < 16) {
      const int i = lane - 8;
      GDEC[t * 8 + i] = -__expf(p.in[I_ALOG][l * 8 + i]) * softplusf(zr[2600 + i] + p.in[I_DTB][l * 8 + i]);
    }
  }
}

__device__ __forceinline__ void phase_delta_local(const Params& p, int l, char* smem) {
  float* Kc = (float*)smem;
  float* Mm = Kc + 64 * 65;
  float* X = Mm + 64 * 64;
  float* gam = X + 64 * 128;
  float* bet = gam + 64;
  float* eg = bet + 64;
  const int tid = ltid(), lane = tid & 63, wave = tid >> 6, r = lane & 31, h = lane >> 5;
  const float* CB = (const float*)(p.ws + OFF_CB);
  const float* BETA = (const float*)(p.ws + OFF_BETA); const float* GDEC = (const float*)(p.ws + OFF_GDEC);
  float* UW = (float*)(p.ws + OFF_UW);
  for (int task = lbid(); task < 1024; task += gridDim.x) {
    const int dir = task & 1, head = (task >> 1) & 3, cgk = task >> 3;
    const int T0 = cgk * 64;
    __syncthreads();
#pragma unroll
    for (int i = 0; i < 16; ++i) {
      const int e = tid + i * 256, row = e >> 6, d = e & 63;
      Kc[row * 65 + d] = CB[(size_t)(T0 + row) * 768 + 256 + head * 64 + d];
    }
    if (wave == 0) {
      const int tr = T0 + rmap(dir, lane);
      float g = GDEC[tr * 8 + dir * 4 + head];
      g = wave_cumsum(g, lane);
      gam[lane] = g;
      eg[lane] = __expf(g);
      bet[lane] = BETA[tr * 8 + dir * 4 + head];
    }
    __syncthreads();
    {
      const int ti = wave >> 1, tj = wave & 1;
      f32x16 acc;
#pragma unroll
      for (int e = 0; e < 16; ++e) acc[e] = 0.f;
      if (tj <= ti) {
        const float* ap = Kc + rmap(dir, ti * 32 + r) * 65 + h;
        const float* bp = Kc + rmap(dir, tj * 32 + r) * 65 + h;
#pragma unroll 8
        for (int k2 = 0; k2 < 32; ++k2) acc = __builtin_amdgcn_mfma_f32_32x32x2f32(ap[2 * k2], bp[2 * k2], acc, 0, 0, 0);
      }
      const int sidx = tj * 32 + r;
      const float gs = gam[sidx];
#pragma unroll
      for (int e = 0; e < 16; ++e) {
        const int tt = ti * 32 + (e & 3) + 8 * (e >> 2) + 4 * h;
        float v = 0.f;
        if (sidx < tt) v = acc[e] * bet[tt] * __expf(gam[tt] - gs);
        Mm[tt * 64 + sidx] = v;
      }
    }
#pragma unroll 4
    for (int i = 0; i < 32; ++i) {
      const int e = tid + i * 256, tt = e >> 7, j = e & 127;
      const int rr = rmap(dir, tt);
      float v;
      if (j < 64) v = CB[(size_t)(T0 + rr) * 768 + 512 + head * 64 + j];
      else v = Kc[rr * 65 + (j - 64)] * eg[tt];
      X[e] = v * bet[tt];
    }
    __syncthreads();
    if (tid < 128) {
      const int j = tid;
      for (int tt = 1; tt < 64; ++tt) {
        float a = X[tt * 128 + j];
        const float* mr = Mm + tt * 64;
        int s2 = 0;
        for (; s2 + 4 <= tt; s2 += 4) {
          const float4 m4 = *(const float4*)(mr + s2);
          a -= m4.x * X[s2 * 128 + j];
          a -= m4.y * X[(s2 + 1) * 128 + j];
          a -= m4.z * X[(s2 + 2) * 128 + j];
          a -= m4.w * X[(s2 + 3) * 128 + j];
        }
        for (; s2 < tt; ++s2) a -= mr[s2] * X[s2 * 128 + j];
        X[tt * 128 + j] = a;
      }
    }
    __syncthreads();
    float* o = UW + (size_t)((cgk * 4 + head) * 2 + dir) * 8192;
#pragma unroll 4
    for (int i = 0; i < 32; ++i) {
      const int e = tid + i * 256, tt = e >> 7, j = e & 127;
      o[(j < 64 ? 0 : 4096) + tt * 64 + (j & 63)] = X[e];
    }
  }
}

__device__ __forceinline__ void delta_scan_item(const Params& p, int l, int seq, int head, int dir, char* smem) {
  float* Wl = (float*)smem;
  float* Kh = Wl + 64 * 65;
  float* gam = Kh + 64 * 65;
  const int tid = ltid(), lane = tid & 63, wave = tid >> 6, c16 = lane & 15, q = lane >> 4;
  const bool lat = seq >= 16;
  const int b = lat ? seq - 16 : seq;
  const int T0s = lat ? 4096 + b * 1024 : b * 256;
  const int nch = lat ? 16 : 4;
  const float* CB = (const float*)(p.ws + OFF_CB);
  const float* GDEC = (const float*)(p.ws + OFF_GDEC);
  float* UW = (float*)(p.ws + OFF_UW);
  float* SDC = (float*)(p.ws + OFF_SDC);
  const int vcol = wave * 16 + c16;
  f32x4 S[4];
  if (lat) {
    const float* s0 = p.in[I_SD] + (size_t)(((b * 4 + l) * 2 + dir) * 4 + head) * 4096;
#pragma unroll
    for (int tr = 0; tr < 4; ++tr)
#pragma unroll
      for (int e = 0; e < 4; ++e) S[tr][e] = s0[(tr * 16 + 4 * q + e) * 64 + vcol];
  } else {
#pragma unroll
    for (int tr = 0; tr < 4; ++tr)
#pragma unroll
      for (int e = 0; e < 4; ++e) S[tr][e] = 0.f;
  }
  for (int cs = 0; cs < nch; ++cs) {
    const int cc = dir ? nch - 1 - cs : cs;
    const int cgk = (T0s >> 6) + cc;
    const int T0 = cgk * 64;
    const size_t tix = (size_t)((cgk * 4 + head) * 2 + dir);
    __syncthreads();
    if (wave == 0) {
      float g = GDEC[(T0 + rmap(dir, lane)) * 8 + dir * 4 + head];
      g = wave_cumsum(g, lane);
      gam[lane] = g;
    }
#pragma unroll
    for (int i = 0; i < 16; ++i) {
      const int e = tid + i * 256, row = e >> 6, d = e & 63;
      Wl[row * 65 + d] = UW[tix * 8192 + 4096 + e];
    }
    __syncthreads();
    const float gl = gam[63];
#pragma unroll
    for (int i = 0; i < 16; ++i) {
      const int e = tid + i * 256, row = e >> 6, d = e & 63;
      Kh[row * 65 + d] = CB[(size_t)(T0 + rmap(dir, row)) * 768 + 256 + head * 64 + d] * __expf(gl - gam[row]);
    }
    __syncthreads();
#pragma unroll
    for (int tr = 0; tr < 4; ++tr)
#pragma unroll
      for (int e = 0; e < 4; ++e) SDC[tix * 4096 + (tr * 16 + 4 * q + e) * 64 + vcol] = S[tr][e];
    f32x4 T[4];
#pragma unroll
    for (int tr = 0; tr < 4; ++tr)
#pragma unroll
      for (int e = 0; e < 4; ++e) T[tr][e] = UW[tix * 8192 + (tr * 16 + 4 * q + e) * 64 + vcol];
#pragma unroll
    for (int ks = 0; ks < 16; ++ks) {
      const int kk = (ks >> 2) * 16 + 4 * q + (ks & 3);
      const float bv = S[ks >> 2][ks & 3];
#pragma unroll
      for (int tr = 0; tr < 4; ++tr) T[tr] = __builtin_amdgcn_mfma_f32_16x16x4f32(-Wl[(tr * 16 + c16) * 65 + kk], bv, T[tr], 0, 0, 0);
      __builtin_amdgcn_sched_barrier(0);
    }
#pragma unroll
    for (int tr = 0; tr < 4; ++tr)
#pragma unroll
      for (int e = 0; e < 4; ++e) UW[tix * 8192 + (tr * 16 + 4 * q + e) * 64 + vcol] = T[tr][e];
    const float egl = __expf(gl);
#pragma unroll
    for (int tr = 0; tr < 4; ++tr)
#pragma unroll
      for (int e = 0; e < 4; ++e) S[tr][e] *= egl;
#pragma unroll
    for (int ks = 0; ks < 16; ++ks) {
      const int ii = (ks >> 2) * 16 + 4 * q + (ks & 3);
      const float bv = T[ks >> 2][ks & 3];
#pragma unroll
      for (int ta = 0; ta < 4; ++ta) S[ta] = __builtin_amdgcn_mfma_f32_16x16x4f32(Kh[ii * 65 + ta * 16 + c16], bv, S[ta], 0, 0, 0);
      __builtin_amdgcn_sched_barrier(0);
    }
  }
  if (!lat) {
    float* o = p.out + O_NSD + (size_t)(((b * 4 + l) * 2 + dir) * 4 + head) * 4096;
#pragma unroll
    for (int tr = 0; tr < 4; ++tr)
#pragma unroll
      for (int e = 0; e < 4; ++e) o[(tr * 16 + 4 * q + e) * 64 + vcol] = S[tr][e];
  }
}

__device__ __forceinline__ void gla_scan_item(const Params& p, int l, int seq, int head, int dir, char* smem) {
  float* Kh = (float*)smem;
  float* segt = Kh + 64 * 33;
  float* blv = segt + 256;
  const int tid = ltid(), lane = tid & 63, wave = tid >> 6, c16 = lane & 15, q = lane >> 4;
  const bool lat = seq >= 16;
  const int b = lat ? seq - 16 : seq;
  const int T0s = lat ? 4096 + b * 1024 : b * 256;
  const int nch = lat ? 16 : 4;
  const float* Z = (const float*)(p.ws + OFF_Z);
  const float* GLOG = (const float*)(p.ws + OFF_GLOG);
  float* SGC = (float*)(p.ws + OFF_SGC);
  const int vcol = wave * 16 + c16;
  const int a = tid & 31, seg = tid >> 5;
  f32x4 S[2];
  if (lat) {
    const float* s0 = p.in[I_SG] + (size_t)(((b * 4 + l) * 2 + dir) * 4 + head) * 2048;
#pragma unroll
    for (int tr = 0; tr < 2; ++tr)
#pragma unroll
      for (int e = 0; e < 4; ++e) S[tr][e] = s0[(tr * 16 + 4 * q + e) * 64 + vcol];
  } else {
#pragma unroll
    for (int tr = 0; tr < 2; ++tr)
#pragma unroll
      for (int e = 0; e < 4; ++e) S[tr][e] = 0.f;
  }
  for (int cs = 0; cs < nch; ++cs) {
    const int cc = dir ? nch - 1 - cs : cs;
    const int cgk = (T0s >> 6) + cc;
    const int T0 = cgk * 64;
    const size_t tix = (size_t)((cgk * 4 + head) * 2 + dir);
    __syncthreads();
    float c8[8]; float run = 0.f;
#pragma unroll
    for (int j = 0; j < 8; ++j) {
      run += GLOG[(size_t)(T0 + rmap(dir, seg * 8 + j)) * 256 + dir * 128 + head * 32 + a];
      c8[j] = run;
    }
    segt[seg * 32 + a] = run;
    __syncthreads();
    float off = 0.f, tot = 0.f;
#pragma unroll
    for (int s2 = 0; s2 < 8; ++s2) { const float v = segt[s2 * 32 + a]; tot += v; if (s2 < seg) off += v; }
    if (seg == 0) blv[a] = tot;
#pragma unroll
    for (int j = 0; j < 8; ++j) {
      const int i = seg * 8 + j;
      const float kv = Z[(size_t)(T0 + rmap(dir, i)) * PW + 896 + head * 32 + a];
      Kh[i * 33 + a] = kv * __expf(tot - (c8[j] + off));
    }
    __syncthreads();
#pragma unroll
    for (int tr = 0; tr < 2; ++tr)
#pragma unroll
      for (int e = 0; e < 4; ++e) SGC[tix * 2048 + (tr * 16 + 4 * q + e) * 64 + vcol] = S[tr][e];
    float vb[16];
#pragma unroll
    for (int ks = 0; ks < 16; ++ks) vb[ks] = Z[(size_t)(T0 + rmap(dir, ks * 4 + q)) * PW + 1024 + head * 64 + vcol];
#pragma unroll
    for (int tr = 0; tr < 2; ++tr)
#pragma unroll
      for (int e = 0; e < 4; ++e) S[tr][e] *= __expf(blv[tr * 16 + 4 * q + e]);
#pragma unroll
    for (int ks = 0; ks < 16; ++ks) {
      const int ii = ks * 4 + q;
#pragma unroll
      for (int ta = 0; ta < 2; ++ta) S[ta] = __builtin_amdgcn_mfma_f32_16x16x4f32(Kh[ii * 33 + ta * 16 + c16], vb[ks], S[ta], 0, 0, 0);
    }
  }
  if (!lat) {
    float* o = p.out + O_NSG + (size_t)(((b * 4 + l) * 2 + dir) * 4 + head) * 2048;
#pragma unroll
    for (int tr = 0; tr < 2; ++tr)
#pragma unroll
      for (int e = 0; e < 4; ++e) o[(tr * 16 + 4 * q + e) * 64 + vcol] = S[tr][e];
  }
}

__device__ __forceinline__ void attn_item(const Params& p, int l, bool lat, int idx, char* smem) {
  u16* sK = (u16*)smem;
  u16* sVt = sK + 64 * 72;
  const int tid = ltid(), lane = tid & 63, wave = tid >> 6, r = lane & 31, h = lane >> 5;
  int b, g, qt, T0, nkeys;
  if (lat) { b = idx >> 6; g = (idx >> 5) & 1; qt = idx & 31; T0 = 4096 + b * 1024; nkeys = 1536; }
  else { b = idx >> 4; g = (idx >> 3) & 1; qt = idx & 7; T0 = b * 256; nkeys = 256; }
  const int q0 = T0 + qt * 32;
  const int hq = g * 4 + wave;
  const u16* QB = (const u16*)(p.ws + OFF_QB); const u16* KB = (const u16*)(p.ws + OFF_KB); const u16* VB = (const u16*)(p.ws + OFF_VB);
  u16* MIXIN = (u16*)(p.ws + OFF_MIXIN);
  bf16x8 qf[4];
#pragma unroll
  for (int s = 0; s < 4; ++s) qf[s] = *(const bf16x8*)(QB + (size_t)(q0 + r) * 512 + hq * 64 + 16 * s + 8 * h);
  f32x16 accO[2];
#pragma unroll
  for (int i = 0; i < 2; ++i)
#pragma unroll
    for (int e = 0; e < 16; ++e) accO[i][e] = 0.f;
  float m_run = -INFINITY, l_run = 0.f;
  const float scale2 = 0.125f * 1.4426950408889634f;
  const int skey = tid >> 2, dq = (tid & 3) * 16;
  for (int key0 = 0; key0 < nkeys; key0 += 64) {
    __syncthreads();
    if (lat && key0 < 512) {
      const float* kp = p.in[I_CK] + ((size_t)(b * 4 + l) * 512 + key0 + skey) * 128 + g * 64 + dq;
      const float* vp = p.in[I_CV] + ((size_t)(b * 4 + l) * 512 + key0 + skey) * 128 + g * 64 + dq;
      float kf[16], vf[16];
#pragma unroll
      for (int i = 0; i < 4; ++i) {
        float4 a4 = *(const float4*)(kp + i * 4); kf[i * 4] = a4.x; kf[i * 4 + 1] = a4.y; kf[i * 4 + 2] = a4.z; kf[i * 4 + 3] = a4.w;
        float4 b4 = *(const float4*)(vp + i * 4); vf[i * 4] = b4.x; vf[i * 4 + 1] = b4.y; vf[i * 4 + 2] = b4.z; vf[i * 4 + 3] = b4.w;
      }
      uint4 q0v, q1v;
      q0v.x = pk2(kf[0], kf[1]); q0v.y = pk2(kf[2], kf[3]); q0v.z = pk2(kf[4], kf[5]); q0v.w = pk2(kf[6], kf[7]);
      q1v.x = pk2(kf[8], kf[9]); q1v.y = pk2(kf[10], kf[11]); q1v.z = pk2(kf[12], kf[13]); q1v.w = pk2(kf[14], kf[15]);
      *(uint4*)(sK + skey * 72 + dq) = q0v; *(uint4*)(sK + skey * 72 + dq + 8) = q1v;
#pragma unroll
      for (int i = 0; i < 16; ++i) sVt[(dq + i) * 72 + skey] = (u16)f2bf(vf[i]);
    } else {
      const int tok = T0 + (lat ? key0 - 512 : key0) + skey;
      const u16* kp = KB + (size_t)tok * 128 + g * 64 + dq;
      const u16* vp = VB + (size_t)tok * 128 + g * 64 + dq;
      uint4 k0 = *(const uint4*)kp, k1 = *(const uint4*)(kp + 8);
      uint4 v0 = *(const uint4*)vp, v1 = *(const uint4*)(vp + 8);
      *(uint4*)(sK + skey * 72 + dq) = k0; *(uint4*)(sK + skey * 72 + dq + 8) = k1;
      const unsigned vw[8] = {v0.x, v0.y, v0.z, v0.w, v1.x, v1.y, v1.z, v1.w};
#pragma unroll
      for (int i = 0; i < 8; ++i) {
        sVt[(dq + 2 * i) * 72 + skey] = (u16)(vw[i] & 0xffffu);
        sVt[(dq + 2 * i + 1) * 72 + skey] = (u16)(vw[i] >> 16);
      }
    }
    __syncthreads();
    f32x16 accS[2];
#pragma unroll
    for (int mt = 0; mt < 2; ++mt) {
#pragma unroll
      for (int e = 0; e < 16; ++e) accS[mt][e] = 0.f;
#pragma unroll
      for (int s = 0; s < 4; ++s) {
        bf16x8 kfr = *(const bf16x8*)(sK + (mt * 32 + r) * 72 + 16 * s + 8 * h);
        accS[mt] = __builtin_amdgcn_mfma_f32_32x32x16_bf16(kfr, qf[s], accS[mt], 0, 0, 0);
      }
    }
    float mx = accS[0][0];
#pragma unroll
    for (int mt = 0; mt < 2; ++mt)
#pragma unroll
      for (int e = 0; e < 16; ++e) mx = fmaxf(mx, accS[mt][e]);
    mx = fmaxf(mx, __shfl_xor(mx, 32));
    const float m_new = fmaxf(m_run, mx * scale2);
    const float alpha = __builtin_amdgcn_exp2f(m_run - m_new);
    m_run = m_new;
    float ls = 0.f;
#pragma unroll
    for (int mt = 0; mt < 2; ++mt)
#pragma unroll
      for (int e = 0; e < 16; ++e) { const float pv = __builtin_amdgcn_exp2f(accS[mt][e] * scale2 - m_new); accS[mt][e] = pv; ls += pv; }
    l_run = l_run * alpha + ls;
#pragma unroll
    for (int i = 0; i < 2; ++i)
#pragma unroll
      for (int e = 0; e < 16; ++e) accO[i][e] *= alpha;
#pragma unroll
    for (int ks = 0; ks < 4; ++ks) {
      const int mt = ks >> 1, base = 8 * (ks & 1);
      union { bf16x8 v; unsigned u[4]; } pf;
#pragma unroll
      for (int j = 0; j < 4; ++j) pf.u[j] = pk2(accS[mt][base + 2 * j], accS[mt][base + 2 * j + 1]);
#pragma unroll
      for (int dt = 0; dt < 2; ++dt) {
        union { bf16x8 v; uint2 u[2]; } vf;
        vf.u[0] = *(const uint2*)(sVt + (dt * 32 + r) * 72 + 16 * ks + 4 * h);
        vf.u[1] = *(const uint2*)(sVt + (dt * 32 + r) * 72 + 16 * ks + 8 + 4 * h);
        accO[dt] = __builtin_amdgcn_mfma_f32_32x32x16_bf16(vf.v, pf.v, accO[dt], 0, 0, 0);
      }
    }
  }
  const float ltot = l_run + __shfl_xor(l_run, 32);
  const float inv = 1.f / ltot;
#pragma unroll
  for (int dt = 0; dt < 2; ++dt)
#pragma unroll
    for (int rg = 0; rg < 4; ++rg) {
      const int d = dt * 32 + 8 * rg + 4 * h;
      uint2 o;
      o.x = pk2(accO[dt][rg * 4 + 0] * inv, accO[dt][rg * 4 + 1] * inv);
      o.y = pk2(accO[dt][rg * 4 + 2] * inv, accO[dt][rg * 4 + 3] * inv);
      *(uint2*)(MIXIN + (size_t)(q0 + r) * 1024 + hq * 64 + d) = o;
    }
}

__device__ __forceinline__ void phase_scan_attn(const Params& p, int l, char* smem) {
  for (int it = lbid(); it < 832; it += gridDim.x) {
    int type, j; bool lat;
    if (it < 32) { type = 0; j = it; lat = true; }
    else if (it < 64) { type = 1; j = it - 32; lat = true; }
    else if (it < 320) { type = 2; j = it - 64; lat = true; }
    else if (it < 448) { type = 0; j = it - 320; lat = false; }
    else if (it < 576) { type = 1; j = it - 448; lat = false; }
    else { type = 2; j = it - 576; lat = false; }
    const int seq = (lat ? 16 : 0) + (j >> 3), head = (j >> 1) & 3, dir = j & 1;
    if (type == 0) delta_scan_item(p, l, seq, head, dir, smem);
    else if (type == 1) gla_scan_item(p, l, seq, head, dir, smem);
    else attn_item(p, l, lat, j, smem);
  }
}

__device__ __forceinline__ void phase_out(const Params& p, int l, char* smem) {
  const int tid = ltid(), lane = tid & 63, wave = tid >> 6, r = lane & 31, h = lane >> 5;
  const float* Z = (const float*)(p.ws + OFF_Z);
  const float* CB = (const float*)(p.ws + OFF_CB);
  const float* GDEC = (const float*)(p.ws + OFF_GDEC);
  const float* GLOG = (const float*)(p.ws + OFF_GLOG);
  const float* UW = (const float*)(p.ws + OFF_UW);
  const float* SDC = (const float*)(p.ws + OFF_SDC);
  const float* SGC = (const float*)(p.ws + OFF_SGC);
  u16* MIXIN = (u16*)(p.ws + OFF_MIXIN);
  const int ti = wave >> 1, tj = wave & 1;
  for (int task = lbid(); task < 1024; task += gridDim.x) {
    const bool isgla = task >= 512;
    const int tk = task & 511;
    const int cgk = tk >> 2, head = tk & 3;
    const int T0 = cgk * 64;
    float* Ob = (float*)smem;
    float* Att = Ob + 64 * 65;
    float* Qs = Att + 64 * 65;
    float* Ks = Qs + 64 * 65;
    float* gam = Ks + 64 * 65;
    __syncthreads();
#pragma unroll
    for (int i = 0; i < 16; ++i) { const int e = tid + i * 256; Ob[(e >> 6) * 65 + (e & 63)] = 0.f; }
    if (!isgla) {
#pragma unroll
      for (int i = 0; i < 16; ++i) {
        const int e = tid + i * 256, row = e >> 6, d = e & 63;
        Qs[row * 65 + d] = CB[(size_t)(T0 + row) * 768 + head * 64 + d];
        Ks[row * 65 + d] = CB[(size_t)(T0 + row) * 768 + 256 + head * 64 + d];
      }
    }
    for (int dir = 0; dir < 2; ++dir) {
      const size_t tix = (size_t)((cgk * 4 + head) * 2 + dir);
      __syncthreads();
      if (!isgla) {
        if (wave == 0) {
          float g = GDEC[(T0 + rmap(dir, lane)) * 8 + dir * 4 + head];
          g = wave_cumsum(g, lane);
          gam[lane] = g;
        }
        __syncthreads();
        {
          f32x16 acc;
#pragma unroll
          for (int e = 0; e < 16; ++e) acc[e] = 0.f;
          if (tj <= ti) {
            const float* ap = Qs + rmap(dir, ti * 32 + r) * 65 + h;
            const float* bp = Ks + rmap(dir, tj * 32 + r) * 65 + h;
#pragma unroll 8
            for (int k2 = 0; k2 < 32; ++k2) acc = __builtin_amdgcn_mfma_f32_32x32x2f32(ap[2 * k2], bp[2 * k2], acc, 0, 0, 0);
          }
          const int sidx = tj * 32 + r;
          const float gs = gam[sidx];
#pragma unroll
          for (int e = 0; e < 16; ++e) {
            const int tt = ti * 32 + (e & 3) + 8 * (e >> 2) + 4 * h;
            Att[tt * 65 + sidx] = (sidx <= tt) ? acc[e] * __expf(gam[tt] - gs) : 0.f;
          }
        }
        __syncthreads();
        {
          f32x16 a1, a2;
#pragma unroll
          for (int e = 0; e < 16; ++e) { a1[e] = 0.f; a2[e] = 0.f; }
          const float* ap = Qs + rmap(dir, ti * 32 + r) * 65 + h;
          const float* sp = SDC + tix * 4096 + h * 64 + tj * 32 + r;
          const float* ap2 = Att + (ti * 32 + r) * 65 + h;
          const float* vp = UW + tix * 8192 + h * 64 + tj * 32 + r;
#pragma unroll 8
          for (int k2 = 0; k2 < 32; ++k2) {
            a1 = __builtin_amdgcn_mfma_f32_32x32x2f32(ap[2 * k2], sp[2 * k2 * 64], a1, 0, 0, 0);
            a2 = __builtin_amdgcn_mfma_f32_32x32x2f32(ap2[2 * k2], vp[2 * k2 * 64], a2, 0, 0, 0);
          }
#pragma unroll
          for (int e = 0; e < 16; ++e) {
            const int tt = ti * 32 + (e & 3) + 8 * (e >> 2) + 4 * h;
            Ob[rmap(dir, tt) * 65 + tj * 32 + r] += a1[e] * __expf(gam[tt]) + a2[e];
          }
        }
      } else {
        float* segt = gam;
        const int a = tid & 31, seg = tid >> 5;
        float c8[8]; float run = 0.f;
#pragma unroll
        for (int j = 0; j < 8; ++j) {
          run += GLOG[(size_t)(T0 + rmap(dir, seg * 8 + j)) * 256 + dir * 128 + head * 32 + a];
          c8[j] = run;
        }
        segt[seg * 32 + a] = run;
        __syncthreads();
        float off = 0.f;
#pragma unroll
        for (int s2 = 0; s2 < 8; ++s2) { const float v = segt[s2 * 32 + a]; if (s2 < seg) off += v; }
#pragma unroll
        for (int j = 0; j < 8; ++j) {
          const int i = seg * 8 + j;
          const float bb = c8[j] + off;
          const float* zr = Z + (size_t)(T0 + rmap(dir, i)) * PW;
          Qs[i * 33 + a] = zr[768 + head * 32 + a] * 0.17677669529663687f * __expf(bb);
          Ks[i * 33 + a] = zr[896 + head * 32 + a] * __expf(-bb);
        }
        __syncthreads();
        {
          f32x16 acc;
#pragma unroll
          for (int e = 0; e < 16; ++e) acc[e] = 0.f;
          if (tj <= ti) {
            const float* ap = Qs + (ti * 32 + r) * 33 + h;
            const float* bp = Ks + (tj * 32 + r) * 33 + h;
#pragma unroll 8
            for (int k2 = 0; k2 < 16; ++k2) acc = __builtin_amdgcn_mfma_f32_32x32x2f32(ap[2 * k2], bp[2 * k2], acc, 0, 0, 0);
          }
          const int sidx = tj * 32 + r;
#pragma unroll
          for (int e = 0; e < 16; ++e) {
            const int tt = ti * 32 + (e & 3) + 8 * (e >> 2) + 4 * h;
            Att[tt * 65 + sidx] = (sidx <= tt) ? acc[e] : 0.f;
          }
        }
        __syncthreads();
        {
          f32x16 a1;
#pragma unroll
          for (int e = 0; e < 16; ++e) a1[e] = 0.f;
          const float* ap = Qs + (ti * 32 + r) * 33 + h;
          const float* sp = SGC + tix * 2048 + h * 64 + tj * 32 + r;
#pragma unroll 8
          for (int k2 = 0; k2 < 16; ++k2) a1 = __builtin_amdgcn_mfma_f32_32x32x2f32(ap[2 * k2], sp[2 * k2 * 64], a1, 0, 0, 0);
          const float* ap2 = Att + (ti * 32 + r) * 65 + h;
#pragma unroll 8
          for (int k2 = 0; k2 < 32; ++k2) {
            const float vv = Z[(size_t)(T0 + rmap(dir, 2 * k2 + h)) * PW + 1024 + head * 64 + tj * 32 + r];
            a1 = __builtin_amdgcn_mfma_f32_32x32x2f32(ap2[2 * k2], vv, a1, 0, 0, 0);
          }
#pragma unroll
          for (int e = 0; e < 16; ++e) {
            const int tt = ti * 32 + (e & 3) + 8 * (e >> 2) + 4 * h;
            Ob[rmap(dir, tt) * 65 + tj * 32 + r] += a1[e];
          }
        }
      }
    }
    __syncthreads();
    {
      const int row = tid >> 2, part = tid & 3;
      float v[16]; float ss = 0.f;
#pragma unroll
      for (int i = 0; i < 16; ++i) { v[i] = Ob[row * 65 + part * 16 + i]; ss += v[i] * v[i]; }
      ss += __shfl_xor(ss, 1); ss += __shfl_xor(ss, 2);
      const float rstd = rsqrtf(ss * (1.f / 64.f) + EPSF);
      const float* gn = isgla ? (p.in[I_GLAN] + l * 64) : (p.in[I_DELN] + l * 64);
      const float* gz = Z + (size_t)(T0 + row) * PW + (isgla ? 1280 : 2336) + head * 64 + part * 16;
      u16* mo = MIXIN + (size_t)(T0 + row) * 1024 + (isgla ? 512 : 768) + head * 64 + part * 16;
      unsigned o[8];
#pragma unroll
      for (int i = 0; i < 8; ++i) {
        const float y0 = v[2 * i] * rstd * gn[part * 16 + 2 * i] * siluf(gz[2 * i]);
        const float y1 = v[2 * i + 1] * rstd * gn[part * 16 + 2 * i + 1] * siluf(gz[2 * i + 1]);
        o[i] = pk2(y0, y1);
      }
      uint4 o0, o1; o0.x = o[0]; o0.y = o[1]; o0.z = o[2]; o0.w = o[3]; o1.x = o[4]; o1.y = o[5]; o1.z = o[6]; o1.w = o[7];
      *(uint4*)mo = o0; *(uint4*)(mo + 8) = o1;
    }
  }
}

__device__ __forceinline__ void run_phase(const Params& p, int ph, char* smem) {
  if (ph == 0) { phase_mod(p, smem); return; }
  const int l = (ph - 1) / 10, s = (ph - 1) % 10;
  const u16* H = (const u16*)(p.ws + OFF_H);
  if (s == 1 || s == 6 || s == 9) {
    const u16* A; int K, N; const float* W; void* o;
    if (s == 1) { A = H; K = 1024; N = PW; W = p.in[I_WIN] + (size_t)l * 1024 * PW; o = p.ws + OFF_Z; }
    else if (s == 6) { A = (const u16*)(p.ws + OFF_MIXIN); K = 1024; N = 1024; W = p.in[I_WOUT] + (size_t)l * 1024 * 1024; o = p.ws + OFF_MIX; }
    else { A = (const u16*)(p.ws + OFF_Z); K = DFF; N = 1024; W = p.in[I_WDOWN] + (size_t)l * DFF * 1024; o = p.ws + OFF_MIX; }
    phase_gemm<0>(A, K, W, nullptr, N, o, smem);
    return;
  }
  if (s == 0 || s == 7) { phase_row(p, l, s == 0 ? 0 : 1); return; }
  switch (s) {
    case 2: phase_prep(p, l); break;
    case 3: phase_delta_local(p, l, smem); break;
    case 4: phase_scan_attn(p, l, smem); break;
    case 5: phase_out(p, l, smem); break;
    case 8: phase_gemm<1>(H, 1024, p.in[I_WGATE] + (size_t)l * 1024 * DFF, p.in[I_WUP] + (size_t)l * 1024 * DFF, DFF, p.ws + OFF_Z, smem); break;
  }
}


#define XB_TMO      128
#define XB_XCNT(j)  (256  + 64 * (j))
#define XB_XSUB(j)  (1280 + 64 * (j))
#define XB_XGEN(j)  (2304 + 64 * (j))
#define XB_TOP      3328
#define XB_TOPGEN   3392
#define XCD_BAR_WORDS 3456
#define XB_SPIN_CAP (1u << 22)
#define LAS __attribute__((address_space(3)))
__device__ __forceinline__ unsigned xb_ld(unsigned* p)              { return __hip_atomic_load(p, __ATOMIC_RELAXED, __HIP_MEMORY_SCOPE_AGENT); }
__device__ __forceinline__ unsigned xb_add(unsigned* p, unsigned v) { return __hip_atomic_fetch_add(p, v, __ATOMIC_RELAXED, __HIP_MEMORY_SCOPE_AGENT); }
__device__ __forceinline__ unsigned xb_xcc_id() { return (unsigned)__builtin_amdgcn_s_getreg((3 << 11) | 20) & 0xFu; }
#define XB_SPIN(cond, bar) do { unsigned _sp = 0; while (cond) { __builtin_amdgcn_s_sleep(1); \
    if ((++_sp & 255u) == 0u) { if (xb_ld(&(bar)[XB_TMO])) break; if (_sp > XB_SPIN_CAP) { atomicAdd(&(bar)[XB_TMO], 1u); break; } } } } while (0)
struct XcdBarrier { unsigned* bar; unsigned x; volatile LAS unsigned* st; };
__device__ __forceinline__ XcdBarrier xcd_barrier_post(unsigned* bar, volatile LAS unsigned* st) {
    XcdBarrier b; b.bar = bar; b.x = xb_xcc_id(); b.st = st;
    if (threadIdx.x == 0) (void)xb_add(&bar[XB_XCNT(b.x)], 1u);
    return b;
}
__device__ __forceinline__ void xcd_barrier_complete(unsigned* bar, unsigned x, unsigned& nloc, unsigned& nx) {
    const unsigned G = gridDim.x * gridDim.y * gridDim.z;
    unsigned sum, cnt, mine, sp = 0u;
    for (;;) {
        sum = 0u; cnt = 0u; mine = 0u;
#pragma unroll
        for (unsigned j = 0; j < 16; ++j) { const unsigned c = xb_ld(&bar[XB_XCNT(j)]); sum += c; cnt += (c > 0u) ? 1u : 0u; mine = (j == x) ? c : mine; }
        if (sum == G) break;
        __builtin_amdgcn_s_sleep(1);
        if ((++sp & 255u) == 0u) { if (xb_ld(&bar[XB_TMO])) break; if (sp > XB_SPIN_CAP) { atomicAdd(&bar[XB_TMO], 1u); break; } }
    }
    nloc = mine > 0u ? mine : 1u; nx = cnt > 0u ? cnt : 1u;
}
__device__ __forceinline__ void xcd_barrier(const XcdBarrier& b) {
    asm volatile("s_waitcnt vmcnt(0)" ::: "memory");
    __syncthreads();
    if (threadIdx.x == 0) {
        unsigned* bar = b.bar;
        __builtin_amdgcn_s_waitcnt(0);
        unsigned nloc = b.st[0], nx = b.st[1];
        if (nloc == 0u) { xcd_barrier_complete(bar, b.x, nloc, nx); b.st[0] = nloc; b.st[1] = nx; }
        const unsigned old = xb_add(&bar[XB_XSUB(b.x)], 1u);
        const unsigned gen = old / nloc;
        if (old + 1u == (gen + 1u) * nloc) {
            __builtin_amdgcn_fence(__ATOMIC_RELEASE, "agent");
            asm volatile("s_waitcnt vmcnt(0)" ::: "memory");
            const unsigned og = xb_add(&bar[XB_TOP], 1u);
            const unsigned tg = og / nx;
            if (og + 1u == (tg + 1u) * nx) xb_add(&bar[XB_TOPGEN], 1u);
            else XB_SPIN(xb_ld(&bar[XB_TOPGEN]) == tg, bar);
            __builtin_amdgcn_fence(__ATOMIC_ACQUIRE, "agent");
            xb_add(&bar[XB_XGEN(b.x)], 1u);
            asm volatile("s_waitcnt vmcnt(0)" ::: "memory");
        } else {
            XB_SPIN(xb_ld(&bar[XB_XGEN(b.x)]) == gen, bar);
            __builtin_amdgcn_fence(__ATOMIC_ACQUIRE, "agent");
            asm volatile("s_waitcnt vmcnt(0)" ::: "memory");
        }
    }
    __syncthreads();
}

__global__ void __launch_bounds__(256, 2) mega(Params p, int ph_lo, int ph_hi) {
  extern __shared__ __attribute__((aligned(16))) char smem[];
  volatile LAS unsigned* st = (volatile LAS unsigned*)(smem + LDS_BYTES - 16);
  if (threadIdx.x == 0) { st[0] = 0u; st[1] = 0u; }
  __syncthreads();
  XcdBarrier xb = xcd_barrier_post((unsigned*)(p.ws + OFF_BAR), st);
  for (int ph = ph_lo; ph < ph_hi; ++ph) {
    if (ph > ph_lo) xcd_barrier(xb);
    run_phase(p, ph, smem);
  }
}

extern "C" void kernel_launch(void* const* d_in, const int* in_sizes, int n_in, void* d_out, int out_size, void* d_ws, size_t ws_size,
                              hipStream_t stream) {
  static int grid_blocks = 0;
  if (!grid_blocks) {
    int dev = 0, cus = 0, per_cu = 0;
    hipGetDevice(&dev);
    hipDeviceGetAttribute(&cus, hipDeviceAttributeMultiprocessorCount, dev);
    hipFuncSetAttribute((const void*)mega, hipFuncAttributeMaxDynamicSharedMemorySize, LDS_BYTES);
    hipOccupancyMaxActiveBlocksPerMultiprocessor(&per_cu, (const void*)mega, 256, LDS_BYTES);
    if (per_cu < 1) per_cu = 1;
    if (per_cu > 2) per_cu = 2;
    grid_blocks = cus * per_cu;
    if (ws_size < WS_END) fprintf(stderr, "kernel_launch: workspace too small (%zu < %zu)\n", ws_size, (size_t)WS_END);
  }
  hipMemsetAsync((char*)d_ws + OFF_BAR, 0, 16384, stream);
  Params p{};
  for (int i = 0; i < 24; ++i) p.in[i] = (const float*)d_in[i];
  p.out = (float*)d_out;
  p.ws = (char*)d_ws;
  int lo = 0, hi = 42;
  void* args[] = {&p, &lo, &hi};
  hipError_t e = hipLaunchCooperativeKernel((const void*)mega, dim3(grid_blocks), dim3(256), args, LDS_BYTES, stream);
  if (e != hipSuccess) fprintf(stderr, "cooperative launch failed: %s (grid %d)\n", hipGetErrorString(e), grid_blocks);
}
```

```cpp
#include <hip/hip_runtime.h>
#include <cstdio>

typedef __attribute__((ext_vector_type(8))) short bf16x8;
typedef __attribute__((ext_vector_type(4))) float f32x4;
typedef __attribute__((ext_vector_type(16))) float f32x16;
typedef unsigned short u16;
#define LAS __attribute__((address_space(3)))

#define NT 8192
#define PW 2608
#define DFF 2816
#define EPSF 1e-6f
#define LDS_BYTES 77824

enum { I_XP = 0, I_XS, I_CK, I_CV, I_SG, I_SD, I_C, I_CCTX, I_WMOD, I_BMOD, I_NG, I_WIN, I_QKG, I_WGG, I_BGG,
       I_GLAN, I_CONVW, I_ALOG, I_DTB, I_DELN, I_WOUT, I_WGATE, I_WUP, I_WDOWN };

constexpr size_t O_NCK = 8388608, O_NCV = 10485760, O_NSG = 12582912, O_NSD = 13631488;

constexpr size_t OFF_MODV = 0;
constexpr size_t OFF_H = 524288;
constexpr size_t OFF_MIXIN = OFF_H + (size_t)NT * 1024 * 2;
constexpr size_t OFF_Z = OFF_MIXIN + (size_t)NT * 1024 * 2;
constexpr size_t OFF_QB = OFF_Z + (size_t)NT * PW * 4;
constexpr size_t OFF_KB = OFF_QB + (size_t)NT * 512 * 2;
constexpr size_t OFF_VB = OFF_KB + (size_t)NT * 128 * 2;
constexpr size_t OFF_CB = OFF_VB + (size_t)NT * 128 * 2;
constexpr size_t OFF_GLOG = OFF_CB + (size_t)NT * 768 * 4;
constexpr size_t OFF_BETA = OFF_GLOG + (size_t)NT * 256 * 4;
constexpr size_t OFF_GDEC = OFF_BETA + (size_t)NT * 8 * 4;
constexpr size_t OFF_UW = OFF_GDEC + (size_t)NT * 8 * 4;
constexpr size_t OFF_SDC = OFF_UW + (size_t)1024 * 12288 * 4;
constexpr size_t OFF_SGC = OFF_SDC + (size_t)1024 * 4096 * 4;
constexpr size_t OFF_MIX = OFF_SGC + (size_t)1024 * 2048 * 4;
constexpr size_t OFF_WT = OFF_MIX + (size_t)NT * 1024 * 2;
constexpr size_t WT_IN = 0, WT_OUT = (size_t)PW * 1024, WT_GATE = WT_OUT + (size_t)1024 * 1024, WT_UP = WT_GATE + (size_t)DFF * 1024,
                 WT_DOWN = WT_UP + (size_t)DFF * 1024, WT_LAYER = WT_DOWN + (size_t)1024 * DFF;
constexpr size_t OFF_DG = OFF_WT + 4 * WT_LAYER * 2;
constexpr size_t OFF_EBL = OFF_DG + (size_t)1024 * 2048 * 4;
constexpr size_t OFF_EGL = OFF_EBL + (size_t)1024 * 32 * 4;
constexpr size_t OFF_CKB = OFF_EGL + 4096;
constexpr size_t OFF_CVB = OFF_CKB + (size_t)4 * 65536 * 2;
constexpr size_t OFF_BAR = OFF_CVB + (size_t)4 * 65536 * 2;
constexpr size_t WS_END = OFF_BAR + 16384;

struct Params {
  const float* in[24];
  float* out;
  char* ws;
};

__device__ __forceinline__ unsigned f2bf(float f) { unsigned u = __float_as_uint(f); return (u + 0x7fffu + ((u >> 16) & 1u)) >> 16; }
typedef __bf16 bf16x2_t __attribute__((ext_vector_type(2)));
typedef float float2_t __attribute__((ext_vector_type(2)));
__device__ __forceinline__ unsigned pk2(float lo, float hi) { float2_t f = {lo, hi}; bf16x2_t r = __builtin_convertvector(f, bf16x2_t); return __builtin_bit_cast(unsigned, r); }
__device__ __forceinline__ float wave_sum(float v) {
#pragma unroll
  for (int o = 32; o; o >>= 1) v += __shfl_xor(v, o);
  return v;
}
__device__ __forceinline__ float siluf(float x) { return x / (1.f + __expf(-x)); }
__device__ __forceinline__ float sigmf(float x) { return 1.f / (1.f + __expf(-x)); }
__device__ __forceinline__ float softplusf(float x) { return x > 20.f ? x : __logf(1.f + __expf(x)); }
__device__ __forceinline__ int rmap(int dir, int i) { return dir ? 63 - i : i; }
__device__ __forceinline__ float wave_cumsum(float v, int lane) {
#pragma unroll
  for (int o = 1; o < 64; o <<= 1) { float t = __shfl_up(v, o); if (lane >= o) v += t; }
  return v;
}

__device__ __forceinline__ int ltid() { int v = threadIdx.x; asm volatile("" : "+v"(v)); return v; }
__device__ __forceinline__ int lbid() { int v = blockIdx.x; asm volatile("" : "+s"(v)); return v; }

__device__ __forceinline__ void phase_mod(const Params& p, char* smem) {
  float* sc = (float*)smem;
  float* red = sc + 5 * 1024;
  const int tid = ltid();
  for (int i = tid; i < 5 * 1024; i += 256) {
    int m = i >> 10, k = i & 1023;
    float c = (m == 0) ? p.in[I_CCTX][k] : p.in[I_C][(m - 1) * 1024 + k];
    sc[i] = siluf(c);
  }
  __syncthreads();
  float* modv = (float*)(p.ws + OFF_MODV);
  const int col = tid & 63, kg = tid >> 6;
  for (int t = lbid(); t < 384; t += gridDim.x) {
    const int l = t / 96, n0 = (t % 96) * 64;
    const float* w = p.in[I_WMOD] + (size_t)l * 1024 * 6144 + (size_t)(kg * 256) * 6144 + n0 + col;
    float a0 = 0.f, a1 = 0.f, a2 = 0.f, a3 = 0.f, a4 = 0.f;
#pragma unroll 16
    for (int k = 0; k < 256; ++k) {
      float wv = w[(size_t)k * 6144];
      int kk = kg * 256 + k;
      a0 += sc[kk] * wv; a1 += sc[1024 + kk] * wv; a2 += sc[2048 + kk] * wv; a3 += sc[3072 + kk] * wv; a4 += sc[4096 + kk] * wv;
    }
    red[(kg * 5 + 0) * 64 + col] = a0; red[(kg * 5 + 1) * 64 + col] = a1; red[(kg * 5 + 2) * 64 + col] = a2;
    red[(kg * 5 + 3) * 64 + col] = a3; red[(kg * 5 + 4) * 64 + col] = a4;
    __syncthreads();
    if (tid < 64) {
      float bb = p.in[I_BMOD][l * 6144 + n0 + col];
#pragma unroll
      for (int m = 0; m < 5; ++m) {
        float s = red[(0 * 5 + m) * 64 + col] + red[(1 * 5 + m) * 64 + col] + red[(2 * 5 + m) * 64 + col] + red[(3 * 5 + m) * 64 + col];
        modv[(size_t)(l * 5 + m) * 6144 + n0 + col] = s + bb;
      }
    }
    __syncthreads();
  }
}

__device__ __forceinline__ void phase_wconv(const Params& p, char* smem, int l, int b0, int nb) {
  float* tile = (float*)smem;
  const int tid = ltid();
  u16* WT = (u16*)(p.ws + OFF_WT);
  const int c0 = 16 * 41, c1 = c0 + 256, c2 = c1 + 704, c3 = c2 + 704, c4 = c3 + 704;
  for (int t = lbid() - b0; t < c4; t += nb) {
    int u = t;
    const float* W; u16* O; int K, N, tk, tn;
    if (u < c0) { W = p.in[I_WIN] + (size_t)l * 1024 * PW; O = WT + l * WT_LAYER + WT_IN; K = 1024; N = PW; tk = u & 15; tn = u >> 4; }
    else if (u < c1) { u -= c0; W = p.in[I_WOUT] + (size_t)l * 1024 * 1024; O = WT + l * WT_LAYER + WT_OUT; K = 1024; N = 1024; tk = u & 15; tn = u >> 4; }
    else if (u < c2) { u -= c1; W = p.in[I_WGATE] + (size_t)l * 1024 * DFF; O = WT + l * WT_LAYER + WT_GATE; K = 1024; N = DFF; tk = u & 15; tn = u >> 4; }
    else if (u < c3) { u -= c2; W = p.in[I_WUP] + (size_t)l * 1024 * DFF; O = WT + l * WT_LAYER + WT_UP; K = 1024; N = DFF; tk = u & 15; tn = u >> 4; }
    else { u -= c3; W = p.in[I_WDOWN] + (size_t)l * DFF * 1024; O = WT + l * WT_LAYER + WT_DOWN; K = DFF; N = 1024; tk = u % 44; tn = u / 44; }
    const int k0 = tk * 64, n0 = tn * 64;
    __syncthreads();
    float wv[16];
#pragma unroll
    for (int i = 0; i < 16; ++i) {
      const int e = tid + i * 256, kk = e >> 6, nn = e & 63;
      int col = n0 + nn; if (col > N - 1) col = N - 1;
      wv[i] = W[(size_t)(k0 + kk) * N + col];
    }
#pragma unroll
    for (int i = 0; i < 16; ++i) {
      const int e = tid + i * 256, kk = e >> 6, nn = e & 63;
      tile[kk * 65 + nn] = wv[i];
    }
    __syncthreads();
#pragma unroll
    for (int i = 0; i < 8; ++i) {
      const int e = tid + i * 256, nn = e >> 5, kp = e & 31;
      if (n0 + nn < N) *(unsigned*)(O + (size_t)(n0 + nn) * K + k0 + 2 * kp) = pk2(tile[(2 * kp) * 65 + nn], tile[(2 * kp + 1) * 65 + nn]);
    }
  }
}

__device__ __forceinline__ void phase_row(const Params& p, int l, int mode) {
  const int lane = ltid() & 63, wave = ltid() >> 6;
  float* X = p.out;
  const u16* MIX = (const u16*)(p.ws + OFF_MIX);
  u16* H = (u16*)(p.ws + OFF_H);
  const float* modv = (const float*)(p.ws + OFF_MODV);
  const float* ng = p.in[I_NG];
  const bool first = (mode == 0 && l == 0);
  for (int row = lbid() * 4 + wave; row < NT; row += gridDim.x * 4) {
    const int m = row < 4096 ? 0 : 1 + ((row - 4096) >> 10);
    const float* xsrc = first ? (row < 4096 ? p.in[I_XP] + (size_t)row * 1024 : p.in[I_XS] + (size_t)(row - 4096) * 1024)
                              : X + (size_t)row * 1024;
    const bool donorm = (mode == 1 || l < 4);
    float4 xv[4], yv4[4], ga4[4], gt4[4], gb4[4], sc4[4], sh4[4];
#pragma unroll
    for (int i = 0; i < 4; ++i) xv[i] = *(const float4*)(xsrc + i * 256 + lane * 4);
    if (!first) {
      const u16* y = MIX + (size_t)row * 1024;
      const float* ga; const float* gate;
      if (mode == 0) { ga = ng + ((l - 1) * 4 + 3) * 1024; gate = modv + (size_t)((l - 1) * 5 + m) * 6144 + 5 * 1024; }
      else { ga = ng + (l * 4 + 1) * 1024; gate = modv + (size_t)(l * 5 + m) * 6144 + 2 * 1024; }
#pragma unroll
      for (int i = 0; i < 4; ++i) {
        { const uint2 yb = *(const uint2*)(y + i * 256 + lane * 4);
          yv4[i].x = __uint_as_float(yb.x << 16); yv4[i].y = __uint_as_float(yb.x & 0xffff0000u);
          yv4[i].z = __uint_as_float(yb.y << 16); yv4[i].w = __uint_as_float(yb.y & 0xffff0000u); }
        ga4[i] = *(const float4*)(ga + i * 256 + lane * 4);
        gt4[i] = *(const float4*)(gate + i * 256 + lane * 4);
      }
    }
    if (donorm) {
      const float* gb = ng + (l * 4 + (mode == 0 ? 0 : 2)) * 1024;
      const float* scale = modv + (size_t)(l * 5 + m) * 6144 + (mode == 0 ? 1 : 4) * 1024;
      const float* shift = modv + (size_t)(l * 5 + m) * 6144 + (mode == 0 ? 0 : 3) * 1024;
#pragma unroll
      for (int i = 0; i < 4; ++i) {
        gb4[i] = *(const float4*)(gb + i * 256 + lane * 4);
        sc4[i] = *(const float4*)(scale + i * 256 + lane * 4);
        sh4[i] = *(const float4*)(shift + i * 256 + lane * 4);
      }
    }
    if (!first) {
      float ss = 0.f;
#pragma unroll
      for (int i = 0; i < 4; ++i) ss += yv4[i].x * yv4[i].x + yv4[i].y * yv4[i].y + yv4[i].z * yv4[i].z + yv4[i].w * yv4[i].w;
      ss = wave_sum(ss);
      const float rstd = rsqrtf(ss * (1.f / 1024.f) + EPSF);
#pragma unroll
      for (int i = 0; i < 4; ++i) {
        xv[i].x += gt4[i].x * (yv4[i].x * rstd * ga4[i].x);
        xv[i].y += gt4[i].y * (yv4[i].y * rstd * ga4[i].y);
        xv[i].z += gt4[i].z * (yv4[i].z * rstd * ga4[i].z);
        xv[i].w += gt4[i].w * (yv4[i].w * rstd * ga4[i].w);
      }
    }
#pragma unroll
    for (int i = 0; i < 4; ++i) *(float4*)(X + (size_t)row * 1024 + i * 256 + lane * 4) = xv[i];
    if (donorm) {
      float ss = 0.f;
#pragma unroll
      for (int i = 0; i < 4; ++i) ss += xv[i].x * xv[i].x + xv[i].y * xv[i].y + xv[i].z * xv[i].z + xv[i].w * xv[i].w;
      ss = wave_sum(ss);
      const float rstd = rsqrtf(ss * (1.f / 1024.f) + EPSF);
#pragma unroll
      for (int i = 0; i < 4; ++i) {
        const float h0 = xv[i].x * rstd * gb4[i].x * (1.f + sc4[i].x) + sh4[i].x;
        const float h1 = xv[i].y * rstd * gb4[i].y * (1.f + sc4[i].y) + sh4[i].y;
        const float h2 = xv[i].z * rstd * gb4[i].z * (1.f + sc4[i].z) + sh4[i].z;
        const float h3 = xv[i].w * rstd * gb4[i].w * (1.f + sc4[i].w) + sh4[i].w;
        uint2 o; o.x = pk2(h0, h1); o.y = pk2(h2, h3);
        *(uint2*)(H + (size_t)row * 1024 + i * 256 + lane * 4) = o;
      }
    }
  }
}

#define GBK 64
template <int EPI>
__device__ __forceinline__ void phase_gemm(const u16* __restrict__ A, int K, const u16* __restrict__ W0, const u16* __restrict__ W1, int N,
                           void* outp, char* smem) {
  char* sA = smem;
  char* sB = smem + 2 * 16384;
  const int tid = ltid(), lane = tid & 63, wave = tid >> 6, r = lane & 31, h = lane >> 5;
  const int wm = wave >> 1, wn = wave & 1;
  const int ntn = (EPI != 1) ? (N + 127) / 128 : N / 64;
  const int ntiles = 64 * ntn;
  const int nk = K / GBK;
  const int srow = wave * 8 + (lane >> 3);
  const int sk = ((lane & 7) ^ ((wave * 4 + (lane >> 4)) & 7)) * 8;
  const int fsw = (r >> 1) & 7;
  for (int t = lbid(); t < ntiles; t += gridDim.x) {
    const int tm = t & 63, tn = t >> 6;
    const int m0 = tm * 128;
    const u16* ap = A + (size_t)(m0 + srow) * K + sk;
    const u16* bp[4];
#pragma unroll
    for (int i = 0; i < 4; ++i) {
      const int nl = srow + 32 * i;
      if (EPI != 1) { int col = tn * 128 + nl; if (col > N - 1) col = N - 1; bp[i] = W0 + (size_t)col * K + sk; }
      else { bp[i] = (nl < 64) ? (W0 + (size_t)(tn * 64 + nl) * K + sk) : (W1 + (size_t)(tn * 64 + nl - 64) * K + sk); }
    }
    f32x16 acc[2][2];
#pragma unroll
    for (int i = 0; i < 2; ++i)
#pragma unroll
      for (int j = 0; j < 2; ++j)
#pragma unroll
        for (int e = 0; e < 16; ++e) acc[i][j][e] = 0.f;
#define GSTAGE(buf, kt) do { _Pragma("unroll") for (int i = 0; i < 4; ++i) { \
      __builtin_amdgcn_global_load_lds((const unsigned*)(ap + (size_t)(32 * i) * K + (kt) * GBK), (LAS unsigned*)(sA + (buf) * 16384 + (i * 32 + wave * 8) * 128), 16, 0, 0); \
      __builtin_amdgcn_global_load_lds((const unsigned*)(bp[i] + (kt) * GBK), (LAS unsigned*)(sB + (buf) * 16384 + (i * 32 + wave * 8) * 128), 16, 0, 0); } } while (0)
    GSTAGE(0, 0);
    asm volatile("s_waitcnt vmcnt(0)" ::: "memory");
    __syncthreads();
    for (int kt = 0; kt < nk; ++kt) {
      if (kt + 1 < nk) GSTAGE((kt + 1) & 1, kt + 1);
      const char* cA = sA + (kt & 1) * 16384;
      const char* cB = sB + (kt & 1) * 16384;
#pragma unroll
      for (int ks = 0; ks < 4; ++ks) {
        bf16x8 af[2], bfr[2];
        const int pos = ((ks * 2 + h) ^ fsw) * 16;
#pragma unroll
        for (int i = 0; i < 2; ++i) af[i] = *(const bf16x8*)(cA + (wm * 64 + i * 32 + r) * 128 + pos);
#pragma unroll
        for (int j = 0; j < 2; ++j) bfr[j] = *(const bf16x8*)(cB + (j * 64 + wn * 32 + r) * 128 + pos);
#pragma unroll
        for (int i = 0; i < 2; ++i)
#pragma unroll
          for (int j = 0; j < 2; ++j) acc[i][j] = __builtin_amdgcn_mfma_f32_32x32x16_bf16(af[i], bfr[j], acc[i][j], 0, 0, 0);
      }
      asm volatile("s_waitcnt vmcnt(0)" ::: "memory");
      __syncthreads();
    }
#undef GSTAGE
    if (EPI == 0) {
      float* C = (float*)outp;
#pragma unroll
      for (int i = 0; i < 2; ++i)
#pragma unroll
        for (int j = 0; j < 2; ++j) {
          const int col = tn * 128 + j * 64 + wn * 32 + r;
          if (col < N) {
#pragma unroll
            for (int e = 0; e < 16; ++e) {
              const int row = m0 + wm * 64 + i * 32 + (e & 3) + 8 * (e >> 2) + 4 * h;
              __hip_atomic_store(&C[(size_t)row * N + col], acc[i][j][e], __ATOMIC_RELAXED, __HIP_MEMORY_SCOPE_AGENT);
            }
          }
        }
    } else if (EPI == 2) {
      u16* C = (u16*)outp;
#pragma unroll
      for (int i = 0; i < 2; ++i)
#pragma unroll
        for (int j = 0; j < 2; ++j) {
          const int col = tn * 128 + j * 64 + wn * 32 + r;
#pragma unroll
          for (int e = 0; e < 16; ++e) {
            const int row = m0 + wm * 64 + i * 32 + (e & 3) + 8 * (e >> 2) + 4 * h;
            C[(size_t)row * N + col] = (u16)f2bf(acc[i][j][e]);
          }
        }
    } else {
      u16* C = (u16*)outp;
#pragma unroll
      for (int i = 0; i < 2; ++i) {
        const int col = tn * 64 + wn * 32 + r;
#pragma unroll
        for (int e = 0; e < 16; ++e) {
          const int row = m0 + wm * 64 + i * 32 + (e & 3) + 8 * (e >> 2) + 4 * h;
          const float g = acc[i][0][e], u = acc[i][1][e];
          C[(size_t)row * N + col] = (u16)f2bf(siluf(g) * u);
        }
      }
    }
  }
}

__device__ __forceinline__ void phase_prep(const Params& p, int l) {
  const int lane = ltid() & 63, wave = ltid() >> 6;
  const float* Z = (const float*)(p.ws + OFF_Z);
  u16* QB = (u16*)(p.ws + OFF_QB); u16* KB = (u16*)(p.ws + OFF_KB); u16* VB = (u16*)(p.ws + OFF_VB);
  float* CB = (float*)(p.ws + OFF_CB); float* GLOG = (float*)(p.ws + OFF_GLOG);
  float* BETA = (float*)(p.ws + OFF_BETA); float* GDEC = (float*)(p.ws + OFF_GDEC);
  const float* qkg = p.in[I_QKG] + l * 128;
  const float* convw = p.in[I_CONVW] + l * 5 * 768;
  const float* wgg = p.in[I_WGG] + l * 2 * 16 * 128;
  const float* bgg = p.in[I_BGG] + l * 256;
  const float LOG2_THETA_16 = 13.287712379549449f / 16.f;
  for (int t = lbid() * 4 + wave; t < NT; t += gridDim.x * 4) {
    const bool lat = t >= 4096;
    const int b = lat ? (t - 4096) >> 10 : t >> 8;
    const int s = lat ? (t - 4096) & 1023 : t & 255;
    const int slen = lat ? 1024 : 256;
    const float* zr = Z + (size_t)t * PW;
    const float prow = (float)(s >> 6), pcol = (float)(s & 63);
    {
      const int head = lane >> 3, sub = lane & 7;
      float v[4][2]; float ss = 0.f;
#pragma unroll
      for (int q = 0; q < 4; ++q) {
        float2 f = *(const float2*)(zr + head * 64 + q * 16 + sub * 2);
        v[q][0] = f.x; v[q][1] = f.y; ss += f.x * f.x + f.y * f.y;
      }
      ss += __shfl_xor(ss, 1); ss += __shfl_xor(ss, 2); ss += __shfl_xor(ss, 4);
      const float rstd = rsqrtf(ss * (1.f / 64.f) + EPSF);
#pragma unroll
      for (int q = 0; q < 4; ++q)
#pragma unroll
        for (int i = 0; i < 2; ++i) v[q][i] *= rstd * qkg[q * 16 + sub * 2 + i];
      if (lat) {
#pragma unroll
        for (int i = 0; i < 2; ++i) {
          const float inv = exp2f(-(float)(sub * 2 + i) * LOG2_THETA_16);
          const float ar = prow * inv, ac = pcol * inv;
          const float cr = __cosf(ar), sr = __sinf(ar), cc = __cosf(ac), sn = __sinf(ac);
          const float a1 = v[0][i], a2 = v[1][i], b1 = v[2][i], b2 = v[3][i];
          v[0][i] = a1 * cr - a2 * sr; v[1][i] = a2 * cr + a1 * sr;
          v[2][i] = b1 * cc - b2 * sn; v[3][i] = b2 * cc + b1 * sn;
        }
      }
#pragma unroll
      for (int q = 0; q < 4; ++q) *(unsigned*)(QB + (size_t)t * 512 + head * 64 + q * 16 + sub * 2) = pk2(v[q][0], v[q][1]);
    }
    {
      const int g = lane >> 5, j = lane & 31;
      const int d0 = j + (j >= 16 ? 16 : 0), d1 = d0 + 16;
      float v0 = zr[512 + g * 64 + d0], v1 = zr[512 + g * 64 + d1];
      float ss = v0 * v0 + v1 * v1;
      ss += __shfl_xor(ss, 1); ss += __shfl_xor(ss, 2); ss += __shfl_xor(ss, 4); ss += __shfl_xor(ss, 8); ss += __shfl_xor(ss, 16);
      const float rstd = rsqrtf(ss * (1.f / 64.f) + EPSF);
      v0 *= rstd * qkg[64 + d0]; v1 *= rstd * qkg[64 + d1];
      if (!lat) {
        float* nk = p.out + O_NCK + ((size_t)(b * 4 + l) * 256 + s) * 128 + g * 64;
        nk[d0] = v0; nk[d1] = v1;
      } else {
        const float inv = exp2f(-(float)(j & 15) * LOG2_THETA_16);
        const float ang = (j < 16 ? prow : pcol) * inv;
        const float c = __cosf(ang), sn = __sinf(ang);
        const float y0 = v0 * c - v1 * sn, y1 = v1 * c + v0 * sn;
        v0 = y0; v1 = y1;
      }
      KB[(size_t)t * 128 + g * 64 + d0] = (u16)f2bf(v0);
      KB[(size_t)t * 128 + g * 64 + d1] = (u16)f2bf(v1);
    }
    {
      float2 f = *(const float2*)(zr + 640 + lane * 2);
      if (!lat) *(float2*)(p.out + O_NCV + ((size_t)(b * 4 + l) * 256 + s) * 128 + lane * 2) = f;
      *(unsigned*)(VB + (size_t)t * 128 + lane * 2) = pk2(f.x, f.y);
    }
    {
#pragma unroll
      for (int it = 0; it < 3; ++it) {
        const int c4 = (it * 64 + lane) * 4;
        float4 acc; acc.x = 0.f; acc.y = 0.f; acc.z = 0.f; acc.w = 0.f;
#pragma unroll
        for (int j = 0; j < 5; ++j) {
          const int sj = s + j - 2;
          if (sj >= 0 && sj < slen) {
            const float4 zv = *(const float4*)(Z + (size_t)(t + j - 2) * PW + 1568 + c4);
            const float4 wv = *(const float4*)(convw + j * 768 + c4);
            acc.x += zv.x * wv.x; acc.y += zv.y * wv.y; acc.z += zv.z * wv.z; acc.w += zv.w * wv.w;
          }
        }
        acc.x = siluf(acc.x); acc.y = siluf(acc.y); acc.z = siluf(acc.z); acc.w = siluf(acc.w);
        if (it < 2) {
          float ss = acc.x * acc.x + acc.y * acc.y + acc.z * acc.z + acc.w * acc.w;
          ss += __shfl_xor(ss, 1); ss += __shfl_xor(ss, 2); ss += __shfl_xor(ss, 4); ss += __shfl_xor(ss, 8);
          const float sc = rsqrtf(ss + EPSF) * (it == 0 ? 0.125f : 1.f);
          acc.x *= sc; acc.y *= sc; acc.z *= sc; acc.w *= sc;
        }
        *(float4*)(CB + (size_t)t * 768 + c4) = acc;
      }
    }
    {
      const int dir = lane >> 5, k4 = (lane & 31) * 4;
      float gc[16];
#pragma unroll
      for (int i = 0; i < 4; ++i) {
        const float4 g4 = *(const float4*)(zr + 1536 + dir * 16 + i * 4);
        gc[i * 4] = g4.x; gc[i * 4 + 1] = g4.y; gc[i * 4 + 2] = g4.z; gc[i * 4 + 3] = g4.w;
      }
      float4 acc = *(const float4*)(bgg + dir * 128 + k4);
#pragma unroll
      for (int rr = 0; rr < 16; ++rr) {
        const float4 w4 = *(const float4*)(wgg + (dir * 16 + rr) * 128 + k4);
        acc.x += gc[rr] * w4.x; acc.y += gc[rr] * w4.y; acc.z += gc[rr] * w4.z; acc.w += gc[rr] * w4.w;
      }
      float4 o;
      o.x = -softplusf(-acc.x) * (1.f / 16.f); o.y = -softplusf(-acc.y) * (1.f / 16.f);
      o.z = -softplusf(-acc.z) * (1.f / 16.f); o.w = -softplusf(-acc.w) * (1.f / 16.f);
      *(float4*)(GLOG + (size_t)t * 256 + dir * 128 + k4) = o;
    }
    if (lane < 8) BETA[t * 8 + lane] = sigmf(zr[2592 + lane]);
    else if (lane < 16) {
      const int i = lane - 8;
      GDEC[t * 8 + i] = -__expf(p.in[I_ALOG][l * 8 + i]) * softplusf(zr[2600 + i] + p.in[I_DTB][l * 8 + i]);
    }
  }
  {
    u16* CKB = (u16*)(p.ws + OFF_CKB); u16* CVB = (u16*)(p.ws + OFF_CVB);
    for (int i = lbid() * 256 + ltid(); i < 4 * 8192; i += gridDim.x * 256) {
      const int b = i >> 13, off = (i & 8191) * 8;
      const float* ks = p.in[I_CK] + (size_t)(b * 4 + l) * 65536 + off;
      const float* vs = p.in[I_CV] + (size_t)(b * 4 + l) * 65536 + off;
      const float4 k0 = *(const float4*)ks, k1 = *(const float4*)(ks + 4), v0 = *(const float4*)vs, v1 = *(const float4*)(vs + 4);
      uint4 ko, vo;
      ko.x = pk2(k0.x, k0.y); ko.y = pk2(k0.z, k0.w); ko.z = pk2(k1.x, k1.y); ko.w = pk2(k1.z, k1.w);
      vo.x = pk2(v0.x, v0.y); vo.y = pk2(v0.z, v0.w); vo.z = pk2(v1.x, v1.y); vo.w = pk2(v1.z, v1.w);
      *(uint4*)(CKB + (size_t)b * 65536 + off) = ko;
      *(uint4*)(CVB + (size_t)b * 65536 + off) = vo;
    }
  }
}

__device__ __forceinline__ void phase_local(const Params& p, int l, char* smem) {
  const int tid = ltid(), lane = tid & 63, wave = tid >> 6, r = lane & 31, h = lane >> 5, c16 = lane & 15, q = lane >> 4;
  const float* CB = (const float*)(p.ws + OFF_CB);
  const float* BETA = (const float*)(p.ws + OFF_BETA); const float* GDEC = (const float*)(p.ws + OFF_GDEC);
  const float* Z = (const float*)(p.ws + OFF_Z);
  const float* GLOG = (const float*)(p.ws + OFF_GLOG);
  float* UW = (float*)(p.ws + OFF_UW);
  float* EGL = (float*)(p.ws + OFF_EGL);
  float* DG = (float*)(p.ws + OFF_DG);
  float* EBL = (float*)(p.ws + OFF_EBL);
  for (int task = lbid(); task < 2048; task += gridDim.x) {
    const int tk = task & 1023;
    const int dir = tk & 1, head = (tk >> 1) & 3, cgk = tk >> 3;
    const int T0 = cgk * 64;
    __syncthreads();
    if (task < 1024) {
      float* Kc = (float*)smem;
      float* Mm = Kc + 64 * 65;
      float* X = Mm + 64 * 68;
      float* gam = X + 64 * 128;
      float* bet = gam + 64;
      float* eg = bet + 64;
#pragma unroll
      for (int i = 0; i < 4; ++i) {
        const int e4 = tid + i * 256, row = e4 >> 4, d4 = (e4 & 15) * 4;
        const float4 kv4 = *(const float4*)(CB + (size_t)(T0 + row) * 768 + 256 + head * 64 + d4);
        Kc[row * 65 + d4] = kv4.x; Kc[row * 65 + d4 + 1] = kv4.y; Kc[row * 65 + d4 + 2] = kv4.z; Kc[row * 65 + d4 + 3] = kv4.w;
      }
      if (wave == 0) {
        const int tr = T0 + rmap(dir, lane);
        float g = GDEC[tr * 8 + dir * 4 + head];
        g = wave_cumsum(g, lane);
        gam[lane] = g;
        eg[lane] = __expf(g);
        bet[lane] = BETA[tr * 8 + dir * 4 + head];
      }
      __syncthreads();
      {
        const int ti = wave >> 1, tj = wave & 1;
        f32x16 acc;
#pragma unroll
        for (int e = 0; e < 16; ++e) acc[e] = 0.f;
        if (tj <= ti) {
          const float* ap = Kc + rmap(dir, ti * 32 + r) * 65 + h;
          const float* bp = Kc + rmap(dir, tj * 32 + r) * 65 + h;
#pragma unroll 8
          for (int k2 = 0; k2 < 32; ++k2) acc = __builtin_amdgcn_mfma_f32_32x32x2f32(ap[2 * k2], bp[2 * k2], acc, 0, 0, 0);
        }
        const int sidx = tj * 32 + r;
        const float gs = gam[sidx];
#pragma unroll
        for (int e = 0; e < 16; ++e) {
          const int tt = ti * 32 + (e & 3) + 8 * (e >> 2) + 4 * h;
          float v = 0.f;
          if (sidx < tt) v = acc[e] * bet[tt] * __expf(gam[tt] - gs);
          Mm[tt * 68 + sidx] = v;
        }
      }
      float* o = UW + (size_t)tk * 12288;
      const float gl = gam[63];
#pragma unroll
      for (int i = 0; i < 4; ++i) {
        const int e4 = tid + i * 256, tt = e4 >> 4, d4 = (e4 & 15) * 4;
        const int rr = rmap(dir, tt);
        const float bt = bet[tt], egt = eg[tt];
        const float4 vv = *(const float4*)(CB + (size_t)(T0 + rr) * 768 + 512 + head * 64 + d4);
        float4 xu; xu.x = vv.x * bt; xu.y = vv.y * bt; xu.z = vv.z * bt; xu.w = vv.w * bt;
        *(float4*)(X + tt * 128 + d4) = xu;
        const float k0 = Kc[rr * 65 + d4], k1 = Kc[rr * 65 + d4 + 1], k2 = Kc[rr * 65 + d4 + 2], k3 = Kc[rr * 65 + d4 + 3];
        float4 xw; xw.x = k0 * egt * bt; xw.y = k1 * egt * bt; xw.z = k2 * egt * bt; xw.w = k3 * egt * bt;
        *(float4*)(X + tt * 128 + 64 + d4) = xw;
      }
      {
        u16* khh = (u16*)(o + 8192); u16* khl = khh + 4096;
#pragma unroll 2
        for (int it = 0; it < 8; ++it) {
          const int idx = tid + it * 256, a = idx >> 5, i0 = (idx & 31) * 2;
          const float v0 = Kc[rmap(dir, i0) * 65 + a] * __expf(gl - gam[i0]);
          const float v1 = Kc[rmap(dir, i0 + 1) * 65 + a] * __expf(gl - gam[i0 + 1]);
          const unsigned h0 = f2bf(v0), h1 = f2bf(v1);
          const unsigned l0 = f2bf(v0 - __uint_as_float(h0 << 16)), l1 = f2bf(v1 - __uint_as_float(h1 << 16));
          *(unsigned*)(khh + a * 64 + i0) = h0 | (h1 << 16);
          *(unsigned*)(khl + a * 64 + i0) = l0 | (l1 << 16);
        }
      }
      if (tid == 0) EGL[tk] = __expf(gl);
      __syncthreads();
#pragma unroll 1
      for (int bk = 0; bk < 4; ++bk) {
        if (tid < 128) {
          float x[16];
#pragma unroll
          for (int t2 = 0; t2 < 16; ++t2) {
            float a = X[(16 * bk + t2) * 128 + tid];
#pragma unroll
            for (int s2 = 0; s2 < t2; ++s2) a -= Mm[(16 * bk + t2) * 68 + 16 * bk + s2] * x[s2];
            x[t2] = a;
          }
#pragma unroll
          for (int t2 = 0; t2 < 16; ++t2) X[(16 * bk + t2) * 128 + tid] = x[t2];
        }
        __syncthreads();
        const int ntile = (3 - bk) * 8;
        for (int tl = wave; tl < ntile; tl += 4) {
          const int rt = bk + 1 + (tl >> 3), ct = tl & 7;
          f32x4 c;
#pragma unroll
          for (int e = 0; e < 4; ++e) c[e] = X[(rt * 16 + 4 * q + e) * 128 + ct * 16 + c16];
#pragma unroll
          for (int ks = 0; ks < 4; ++ks)
            c = __builtin_amdgcn_mfma_f32_16x16x4f32(-Mm[(rt * 16 + c16) * 68 + 16 * bk + 4 * ks + q], X[(16 * bk + 4 * ks + q) * 128 + ct * 16 + c16], c, 0, 0, 0);
#pragma unroll
          for (int e = 0; e < 4; ++e) X[(rt * 16 + 4 * q + e) * 128 + ct * 16 + c16] = c[e];
        }
        __syncthreads();
      }
#pragma unroll
      for (int i = 0; i < 8; ++i) {
        const int e4 = tid + i * 256, tt = e4 >> 5, j4 = (e4 & 31) * 4;
        const float4 xv = *(const float4*)(X + tt * 128 + j4);
        if (j4 < 64) *(float4*)(o + tt * 64 + j4) = xv;
        else {
          u16* wh = (u16*)(o + 4096); u16* wl = wh + 4096;
          const unsigned h0 = f2bf(xv.x), h1 = f2bf(xv.y), h2 = f2bf(xv.z), h3 = f2bf(xv.w);
          uint2 hv, lv;
          hv.x = h0 | (h1 << 16); hv.y = h2 | (h3 << 16);
          lv.x = f2bf(xv.x - __uint_as_float(h0 << 16)) | (f2bf(xv.y - __uint_as_float(h1 << 16)) << 16);
          lv.y = f2bf(xv.z - __uint_as_float(h2 << 16)) | (f2bf(xv.w - __uint_as_float(h3 << 16)) << 16);
          *(uint2*)(wh + tt * 64 + (j4 - 64)) = hv;
          *(uint2*)(wl + tt * 64 + (j4 - 64)) = lv;
        }
      }
    } else {
      float* Kh = (float*)smem;
      float* segt = Kh + 64 * 33;
      const int a = tid & 31, seg = tid >> 5;
      float c8[8]; float run = 0.f;
#pragma unroll
      for (int j = 0; j < 8; ++j) {
        run += GLOG[(size_t)(T0 + rmap(dir, seg * 8 + j)) * 256 + dir * 128 + head * 32 + a];
        c8[j] = run;
      }
      float kv[8];
#pragma unroll
      for (int j = 0; j < 8; ++j) kv[j] = Z[(size_t)(T0 + rmap(dir, seg * 8 + j)) * PW + 896 + head * 32 + a];
      segt[seg * 32 + a] = run;
      __syncthreads();
      float off = 0.f, tot = 0.f;
#pragma unroll
      for (int s2 = 0; s2 < 8; ++s2) { const float v = segt[s2 * 32 + a]; tot += v; if (s2 < seg) off += v; }
      if (seg == 0) EBL[tk * 32 + a] = __expf(tot);
#pragma unroll
      for (int j = 0; j < 8; ++j) Kh[(seg * 8 + j) * 33 + a] = kv[j] * __expf(tot - (c8[j] + off));
      __syncthreads();
      const int vcol = wave * 16 + c16;
      float vb[16];
#pragma unroll
      for (int ks = 0; ks < 16; ++ks) vb[ks] = Z[(size_t)(T0 + rmap(dir, ks * 4 + q)) * PW + 1024 + head * 64 + vcol];
      f32x4 D[2];
#pragma unroll
      for (int ta = 0; ta < 2; ++ta)
#pragma unroll
        for (int e = 0; e < 4; ++e) D[ta][e] = 0.f;
#pragma unroll
      for (int ks = 0; ks < 16; ++ks) {
        const int ii = ks * 4 + q;
#pragma unroll
        for (int ta = 0; ta < 2; ++ta) D[ta] = __builtin_amdgcn_mfma_f32_16x16x4f32(Kh[ii * 33 + ta * 16 + c16], vb[ks], D[ta], 0, 0, 0);
      }
#pragma unroll
      for (int ta = 0; ta < 2; ++ta)
#pragma unroll
        for (int e = 0; e < 4; ++e) DG[(size_t)tk * 2048 + (ta * 16 + 4 * q + e) * 64 + vcol] = D[ta][e];
    }
  }
}

__device__ __forceinline__ bf16x8 split_hi(const f32x4& x0, const f32x4& x1, f32x4& r0, f32x4& r1) {
  union { bf16x8 v; unsigned u[4]; } o;
  unsigned hh[8];
#pragma unroll
  for (int e = 0; e < 4; ++e) { hh[e] = f2bf(x0[e]); hh[4 + e] = f2bf(x1[e]); r0[e] = x0[e] - __uint_as_float(hh[e] << 16); r1[e] = x1[e] - __uint_as_float(hh[4 + e] << 16); }
#pragma unroll
  for (int j = 0; j < 4; ++j) o.u[j] = hh[2 * j] | (hh[2 * j + 1] << 16);
  return o.v;
}
__device__ __forceinline__ bf16x8 pack_bf(const f32x4& x0, const f32x4& x1) {
  union { bf16x8 v; unsigned u[4]; } o;
  o.u[0] = pk2(x0[0], x0[1]); o.u[1] = pk2(x0[2], x0[3]); o.u[2] = pk2(x1[0], x1[1]); o.u[3] = pk2(x1[2], x1[3]);
  return o.v;
}
__device__ __forceinline__ void delta_scan_item(const Params& p, int l, int seq, int head, int dir, char* smem) {
  const int tid = ltid(), lane = tid & 63, wave = tid >> 6, c16 = lane & 15, q = lane >> 4;
  const bool lat = seq >= 16;
  const int b = lat ? seq - 16 : seq;
  const int T0s = lat ? 4096 + b * 1024 : b * 256;
  const int nch = lat ? 16 : 4;
  float* UW = (float*)(p.ws + OFF_UW);
  float* SDC = (float*)(p.ws + OFF_SDC);
  const float* EGL = (const float*)(p.ws + OFF_EGL);
  const int vcol = wave * 16 + c16;
  f32x4 S[4];
  if (lat) {
    const float* s0 = p.in[I_SD] + (size_t)(((b * 4 + l) * 2 + dir) * 4 + head) * 4096;
#pragma unroll
    for (int tr = 0; tr < 4; ++tr)
#pragma unroll
      for (int e = 0; e < 4; ++e) S[tr][e] = s0[(tr * 16 + 4 * q + e) * 64 + vcol];
  } else {
#pragma unroll
    for (int tr = 0; tr < 4; ++tr)
#pragma unroll
      for (int e = 0; e < 4; ++e) S[tr][e] = 0.f;
  }
  const int soff = (lane >> 3) * 128 + (((lane & 7) ^ (lane >> 3)) * 16);
#define DSTAGE(buf, tixv) do { const char* gsrc = (const char*)(UW + (size_t)(tixv) * 12288 + 4096); _Pragma("unroll") for (int i = 0; i < 8; ++i) { \
      __builtin_amdgcn_global_load_lds((const unsigned*)(gsrc + (wave * 8 + i) * 1024 + soff), (LAS unsigned*)(smem + (buf) * 32768 + (wave * 8 + i) * 1024), 16, 0, 0); } } while (0)
  const int foff = c16 * 128 + 8 * (q & 1);
  const int fch = (q >> 1);
  const int fsw = c16 & 7;
#define FRAG(img, tile, s2) ({ union { bf16x8 v; uint2 u[2]; } f_; const char* b_ = (img) + (tile) * 2048 + foff; \
      f_.u[0] = *(const uint2*)(b_ + (((4 * (s2) + fch) ^ fsw) * 16)); f_.u[1] = *(const uint2*)(b_ + (((4 * (s2) + 2 + fch) ^ fsw) * 16)); f_.v; })
  __syncthreads();
  {
    const int cc0 = dir ? nch - 1 : 0;
    DSTAGE(0, (((T0s >> 6) + cc0) * 4 + head) * 2 + dir);
  }
  f32x4 Uv[4]; float egl;
  {
    const int cc0 = dir ? nch - 1 : 0;
    const size_t tix0 = (size_t)((((T0s >> 6) + cc0) * 4 + head) * 2 + dir);
#pragma unroll
    for (int tr = 0; tr < 4; ++tr)
#pragma unroll
      for (int e = 0; e < 4; ++e) Uv[tr][e] = UW[tix0 * 12288 + (tr * 16 + 4 * q + e) * 64 + vcol];
    egl = EGL[tix0];
  }
  asm volatile("s_waitcnt vmcnt(0)" ::: "memory");
  __syncthreads();
  f32x4 Sp[4], T[4]; size_t tixp = 0;
  for (int cs = 0; cs < nch; ++cs) {
    const int cc = dir ? nch - 1 - cs : cs;
    const int cgk = (T0s >> 6) + cc;
    const size_t tix = (size_t)((cgk * 4 + head) * 2 + dir);
    const int ccn = (cs + 1 < nch) ? (dir ? nch - 2 - cs : cs + 1) : cc;
    const size_t tixn = (size_t)((((T0s >> 6) + ccn) * 4 + head) * 2 + dir);
    f32x4 Un[4];
#pragma unroll
    for (int tr = 0; tr < 4; ++tr)
#pragma unroll
      for (int e = 0; e < 4; ++e) Un[tr][e] = UW[tixn * 12288 + (tr * 16 + 4 * q + e) * 64 + vcol];
    const float egln = EGL[tixn];
    asm volatile("" ::: "memory");
    if (cs + 1 < nch) DSTAGE((cs + 1) & 1, tixn);
    asm volatile("" ::: "memory");
    if (cs > 0) {
#pragma unroll
      for (int tr = 0; tr < 4; ++tr)
#pragma unroll
        for (int e = 0; e < 4; ++e) {
          SDC[tixp * 4096 + (tr * 16 + 4 * q + e) * 64 + vcol] = Sp[tr][e];
          UW[tixp * 12288 + (tr * 16 + 4 * q + e) * 64 + vcol] = T[tr][e];
        }
    }
    asm volatile("" ::: "memory");
    const char* Whi = smem + (cs & 1) * 32768;
    const char* Wlo = Whi + 8192;
    const char* Khi = Whi + 16384;
    const char* Klo = Whi + 24576;
#pragma unroll
    for (int tr = 0; tr < 4; ++tr) Sp[tr] = S[tr];
    {
      bf16x8 bh[2], bl[2];
#pragma unroll
      for (int s2 = 0; s2 < 2; ++s2) { f32x4 r0, r1; bh[s2] = split_hi(S[2 * s2], S[2 * s2 + 1], r0, r1); bl[s2] = pack_bf(r0, r1); }
#pragma unroll
      for (int tr = 0; tr < 4; ++tr) {
        f32x4 acc = {0.f, 0.f, 0.f, 0.f};
#pragma unroll
        for (int s2 = 0; s2 < 2; ++s2) {
          const bf16x8 ah = FRAG(Whi, tr, s2);
          const bf16x8 al = FRAG(Wlo, tr, s2);
          acc = __builtin_amdgcn_mfma_f32_16x16x32_bf16(ah, bh[s2], acc, 0, 0, 0);
          acc = __builtin_amdgcn_mfma_f32_16x16x32_bf16(ah, bl[s2], acc, 0, 0, 0);
          acc = __builtin_amdgcn_mfma_f32_16x16x32_bf16(al, bh[s2], acc, 0, 0, 0);
        }
#pragma unroll
        for (int e = 0; e < 4; ++e) T[tr][e] = Uv[tr][e] - acc[e];
      }
    }
    {
      bf16x8 bh[2], bl[2];
#pragma unroll
      for (int s2 = 0; s2 < 2; ++s2) { f32x4 r0, r1; bh[s2] = split_hi(T[2 * s2], T[2 * s2 + 1], r0, r1); bl[s2] = pack_bf(r0, r1); }
#pragma unroll
      for (int ta = 0; ta < 4; ++ta) {
        f32x4 acc;
#pragma unroll
        for (int e = 0; e < 4; ++e) acc[e] = S[ta][e] * egl;
#pragma unroll
        for (int s2 = 0; s2 < 2; ++s2) {
          const bf16x8 ah = FRAG(Khi, ta, s2);
          const bf16x8 al = FRAG(Klo, ta, s2);
          acc = __builtin_amdgcn_mfma_f32_16x16x32_bf16(ah, bh[s2], acc, 0, 0, 0);
          acc = __builtin_amdgcn_mfma_f32_16x16x32_bf16(ah, bl[s2], acc, 0, 0, 0);
          acc = __builtin_amdgcn_mfma_f32_16x16x32_bf16(al, bh[s2], acc, 0, 0, 0);
        }
        S[ta] = acc;
      }
    }
    tixp = tix;
    asm volatile("s_waitcnt vmcnt(0)" ::: "memory");
#pragma unroll
    for (int tr = 0; tr < 4; ++tr) Uv[tr] = Un[tr];
    egl = egln;
    __syncthreads();
  }
#pragma unroll
  for (int tr = 0; tr < 4; ++tr)
#pragma unroll
    for (int e = 0; e < 4; ++e) {
      SDC[tixp * 4096 + (tr * 16 + 4 * q + e) * 64 + vcol] = Sp[tr][e];
      UW[tixp * 12288 + (tr * 16 + 4 * q + e) * 64 + vcol] = T[tr][e];
    }
#undef DSTAGE
#undef FRAG
  if (!lat) {
    float* o = p.out + O_NSD + (size_t)(((b * 4 + l) * 2 + dir) * 4 + head) * 4096;
#pragma unroll
    for (int tr = 0; tr < 4; ++tr)
#pragma unroll
      for (int e = 0; e < 4; ++e) o[(tr * 16 + 4 * q + e) * 64 + vcol] = S[tr][e];
  }
}

__device__ __forceinline__ void gla_scan_item(const Params& p, int l, int seq, int head, int dir, char* smem) {
  const int tid = ltid();
  const bool lat = seq >= 16;
  const int b = lat ? seq - 16 : seq;
  const int T0s = lat ? 4096 + b * 1024 : b * 256;
  const int nch = lat ? 16 : 4;
  const float* DG = (const float*)(p.ws + OFF_DG);
  const float* EBL = (const float*)(p.ws + OFF_EBL);
  float* SGC = (float*)(p.ws + OFF_SGC);
  const int e0 = tid * 8, krow = tid >> 3;
  float S[8];
  if (lat) {
    const float* s0 = p.in[I_SG] + (size_t)(((b * 4 + l) * 2 + dir) * 4 + head) * 2048 + e0;
    const float4 a4 = *(const float4*)s0, b4 = *(const float4*)(s0 + 4);
    S[0] = a4.x; S[1] = a4.y; S[2] = a4.z; S[3] = a4.w; S[4] = b4.x; S[5] = b4.y; S[6] = b4.z; S[7] = b4.w;
  } else {
#pragma unroll
    for (int i = 0; i < 8; ++i) S[i] = 0.f;
  }
  for (int cs0 = 0; cs0 < nch; cs0 += 4) {
    float4 d0[4], d1[4]; float eb[4];
#pragma unroll
    for (int u = 0; u < 4; ++u) {
      const int cs = cs0 + u;
      const int cc = dir ? nch - 1 - cs : cs;
      const size_t tix = (size_t)((((T0s >> 6) + cc) * 4 + head) * 2 + dir);
      d0[u] = *(const float4*)(DG + tix * 2048 + e0); d1[u] = *(const float4*)(DG + tix * 2048 + e0 + 4);
      eb[u] = EBL[tix * 32 + krow];
    }
#pragma unroll
    for (int u = 0; u < 4; ++u) {
      const int cs = cs0 + u;
      const int cc = dir ? nch - 1 - cs : cs;
      const size_t tix = (size_t)((((T0s >> 6) + cc) * 4 + head) * 2 + dir);
      float4 o0, o1; o0.x = S[0]; o0.y = S[1]; o0.z = S[2]; o0.w = S[3]; o1.x = S[4]; o1.y = S[5]; o1.z = S[6]; o1.w = S[7];
      *(float4*)(SGC + tix * 2048 + e0) = o0; *(float4*)(SGC + tix * 2048 + e0 + 4) = o1;
      S[0] = eb[u] * S[0] + d0[u].x; S[1] = eb[u] * S[1] + d0[u].y; S[2] = eb[u] * S[2] + d0[u].z; S[3] = eb[u] * S[3] + d0[u].w;
      S[4] = eb[u] * S[4] + d1[u].x; S[5] = eb[u] * S[5] + d1[u].y; S[6] = eb[u] * S[6] + d1[u].z; S[7] = eb[u] * S[7] + d1[u].w;
    }
  }
  if (!lat) {
    float* o = p.out + O_NSG + (size_t)(((b * 4 + l) * 2 + dir) * 4 + head) * 2048 + e0;
    float4 o0, o1; o0.x = S[0]; o0.y = S[1]; o0.z = S[2]; o0.w = S[3]; o1.x = S[4]; o1.y = S[5]; o1.z = S[6]; o1.w = S[7];
    *(float4*)o = o0; *(float4*)(o + 4) = o1;
  }
}

__device__ __forceinline__ void attn_item(const Params& p, int l, bool lat, int idx, char* smem) {
  char* sK = smem;
  u16* sVt = (u16*)(smem + 16384);
  const int tid = ltid(), lane = tid & 63, wave = tid >> 6, r = lane & 31, h = lane >> 5;
  int b, g, qt, T0, nkeys;
  if (lat) { b = idx >> 6; g = (idx >> 5) & 1; qt = idx & 31; T0 = 4096 + b * 1024; nkeys = 1536; }
  else { b = idx >> 4; g = (idx >> 3) & 1; qt = idx & 7; T0 = b * 256; nkeys = 256; }
  const int q0 = T0 + qt * 32;
  const int hq = g * 4 + wave;
  const u16* QB = (const u16*)(p.ws + OFF_QB); const u16* KB = (const u16*)(p.ws + OFF_KB); const u16* VB = (const u16*)(p.ws + OFF_VB);
  const u16* CKB = (const u16*)(p.ws + OFF_CKB) + (size_t)b * 65536; const u16* CVB = (const u16*)(p.ws + OFF_CVB) + (size_t)b * 65536;
  u16* MIXIN = (u16*)(p.ws + OFF_MIXIN);
  bf16x8 qf[4];
#pragma unroll
  for (int s = 0; s < 4; ++s) qf[s] = *(const bf16x8*)(QB + (size_t)(q0 + r) * 512 + hq * 64 + 16 * s + 8 * h);
  f32x16 accO[2];
#pragma unroll
  for (int i = 0; i < 2; ++i)
#pragma unroll
    for (int e = 0; e < 16; ++e) accO[i][e] = 0.f;
  float m_run = -INFINITY, l_run = 0.f;
  const float scale2 = 0.125f * 1.4426950408889634f;
  const int skey = tid >> 2, dq = (tid & 3) * 16;
  const int krow = (lane >> 3), kpos = lane & 7;
  const int fsw = (r >> 1) & 7;
#define KV_ROWS(key0, kp, vp) do { if (lat && (key0) < 512) { kp = CKB + (size_t)(key0) * 128 + g * 64; vp = CVB + (size_t)(key0) * 128 + g * 64; } \
      else { const int t0_ = T0 + (lat ? (key0) - 512 : (key0)); kp = KB + (size_t)t0_ * 128 + g * 64; vp = VB + (size_t)t0_ * 128 + g * 64; } } while (0)
#define K_STAGE(buf, kp) do { _Pragma("unroll") for (int i = 0; i < 2; ++i) { const int row = (wave * 2 + i) * 8 + krow; \
      __builtin_amdgcn_global_load_lds((const unsigned*)((kp) + (size_t)row * 128 + ((kpos ^ ((row >> 1) & 7)) * 8)), \
                                       (LAS unsigned*)(sK + (buf) * 8192 + (wave * 2 + i) * 1024), 16, 0, 0); } } while (0)
  uint4 v0, v1;
  __syncthreads();
  {
    const u16* kp; const u16* vp; KV_ROWS(0, kp, vp);
    K_STAGE(0, kp);
    v0 = *(const uint4*)(vp + (size_t)skey * 128 + dq); v1 = *(const uint4*)(vp + (size_t)skey * 128 + dq + 8);
  }
  const int ntile = nkeys >> 6;
  for (int kt = 0; kt < ntile; ++kt) {
    {
      u16* dst = sVt + (kt & 1) * 64 * 72;
      const unsigned vw[8] = {v0.x, v0.y, v0.z, v0.w, v1.x, v1.y, v1.z, v1.w};
#pragma unroll
      for (int i = 0; i < 8; ++i) {
        dst[(dq + 2 * i) * 72 + skey] = (u16)(vw[i] & 0xffffu);
        dst[(dq + 2 * i + 1) * 72 + skey] = (u16)(vw[i] >> 16);
      }
    }
    asm volatile("s_waitcnt vmcnt(0)" ::: "memory");
    __syncthreads();
    if (kt + 1 < ntile) {
      const u16* kp; const u16* vp; KV_ROWS((kt + 1) * 64, kp, vp);
      K_STAGE((kt + 1) & 1, kp);
      v0 = *(const uint4*)(vp + (size_t)skey * 128 + dq); v1 = *(const uint4*)(vp + (size_t)skey * 128 + dq + 8);
    }
    const char* cK = sK + (kt & 1) * 8192;
    const u16* cV = sVt + (kt & 1) * 64 * 72;
    f32x16 accS[2];
#pragma unroll
    for (int mt = 0; mt < 2; ++mt) {
#pragma unroll
      for (int e = 0; e < 16; ++e) accS[mt][e] = 0.f;
#pragma unroll
      for (int s = 0; s < 4; ++s) {
        bf16x8 kfr = *(const bf16x8*)(cK + (mt * 32 + r) * 128 + (((2 * s + h) ^ fsw) * 16));
        accS[mt] = __builtin_amdgcn_mfma_f32_32x32x16_bf16(kfr, qf[s], accS[mt], 0, 0, 0);
      }
    }
    float mx = accS[0][0];
#pragma unroll
    for (int mt = 0; mt < 2; ++mt)
#pragma unroll
      for (int e = 0; e < 16; ++e) mx = fmaxf(mx, accS[mt][e]);
    mx = fmaxf(mx, __shfl_xor(mx, 32));
    const float m_new = fmaxf(m_run, mx * scale2);
    const float alpha = __builtin_amdgcn_exp2f(m_run - m_new);
    m_run = m_new;
    float ls = 0.f;
#pragma unroll
    for (int mt = 0; mt < 2; ++mt)
#pragma unroll
      for (int e = 0; e < 16; ++e) { const float pv = __builtin_amdgcn_exp2f(accS[mt][e] * scale2 - m_new); accS[mt][e] = pv; ls += pv; }
    l_run = l_run * alpha + ls;
#pragma unroll
    for (int i = 0; i < 2; ++i)
#pragma unroll
      for (int e = 0; e < 16; ++e) accO[i][e] *= alpha;
#pragma unroll
    for (int ks = 0; ks < 4; ++ks) {
      const int mt = ks >> 1, base = 8 * (ks & 1);
      union { bf16x8 v; unsigned u[4]; } pf;
#pragma unroll
      for (int j = 0; j < 4; ++j) pf.u[j] = pk2(accS[mt][base + 2 * j], accS[mt][base + 2 * j + 1]);
#pragma unroll
      for (int dt = 0; dt < 2; ++dt) {
        union { bf16x8 v; uint2 u[2]; } vf;
        vf.u[0] = *(const uint2*)(cV + (dt * 32 + r) * 72 + 16 * ks + 4 * h);
        vf.u[1] = *(const uint2*)(cV + (dt * 32 + r) * 72 + 16 * ks + 8 + 4 * h);
        accO[dt] = __builtin_amdgcn_mfma_f32_32x32x16_bf16(vf.v, pf.v, accO[dt], 0, 0, 0);
      }
    }
  }
#undef KV_ROWS
#undef K_STAGE
  const float ltot = l_run + __shfl_xor(l_run, 32);
  const float inv = 1.f / ltot;
#pragma unroll
  for (int dt = 0; dt < 2; ++dt)
#pragma unroll
    for (int rg = 0; rg < 4; ++rg) {
      const int d = dt * 32 + 8 * rg + 4 * h;
      uint2 o;
      o.x = pk2(accO[dt][rg * 4 + 0] * inv, accO[dt][rg * 4 + 1] * inv);
      o.y = pk2(accO[dt][rg * 4 + 2] * inv, accO[dt][rg * 4 + 3] * inv);
      *(uint2*)(MIXIN + (size_t)(q0 + r) * 1024 + hq * 64 + d) = o;
    }
}

__device__ __forceinline__ void phase_scan_attn(const Params& p, int l, char* smem) {
  for (int it = lbid(); it < 832; it += gridDim.x) {
    int type, j; bool lat;
    if (it < 32) { type = 0; j = it; lat = true; }
    else if (it < 64) { type = 1; j = it - 32; lat = true; }
    else if (it < 320) { type = 2; j = it - 64; lat = true; }
    else if (it < 448) { type = 0; j = it - 320; lat = false; }
    else if (it < 576) { type = 1; j = it - 448; lat = false; }
    else { type = 2; j = it - 576; lat = false; }
    const int seq = (lat ? 16 : 0) + (j >> 3), head = (j >> 1) & 3, dir = j & 1;
    if (type == 0) delta_scan_item(p, l, seq, head, dir, smem);
    else if (type == 1) gla_scan_item(p, l, seq, head, dir, smem);
    else attn_item(p, l, lat, j, smem);
  }
  if (l < 3 && (int)gridDim.x > 384 && lbid() >= 320) phase_wconv(p, smem, l + 1, 320, gridDim.x - 320);
  else if (l < 3 && (int)gridDim.x <= 384) phase_wconv(p, smem, l + 1, 0, gridDim.x);
}

__device__ __forceinline__ void phase_out(const Params& p, int l, char* smem) {
  const int tid = ltid(), lane = tid & 63, wave = tid >> 6, r = lane & 31, h = lane >> 5;
  const float* Z = (const float*)(p.ws + OFF_Z);
  const float* CB = (const float*)(p.ws + OFF_CB);
  const float* GDEC = (const float*)(p.ws + OFF_GDEC);
  const float* GLOG = (const float*)(p.ws + OFF_GLOG);
  const float* UW = (const float*)(p.ws + OFF_UW);
  const float* SDC = (const float*)(p.ws + OFF_SDC);
  const float* SGC = (const float*)(p.ws + OFF_SGC);
  u16* MIXIN = (u16*)(p.ws + OFF_MIXIN);
  const int ti = wave >> 1, tj = wave & 1;
  for (int task = lbid(); task < 1024; task += gridDim.x) {
    const bool isgla = task >= 512;
    const int tk = task & 511;
    const int cgk = tk >> 2, head = tk & 3;
    const int T0 = cgk * 64;
    float* Ob = (float*)smem;
    float* Att = Ob + 64 * 65;
    float* Qs = Att + 64 * 65;
    float* Ks = Qs + 64 * 65;
    float* gam = Ks + 64 * 65;
    __syncthreads();
#pragma unroll
    for (int i = 0; i < 16; ++i) { const int e = tid + i * 256; Ob[(e >> 6) * 65 + (e & 63)] = 0.f; }
    if (!isgla) {
#pragma unroll
      for (int i = 0; i < 4; ++i) {
        const int e4 = tid + i * 256, row = e4 >> 4, d4 = (e4 & 15) * 4;
        const float4 q4 = *(const float4*)(CB + (size_t)(T0 + row) * 768 + head * 64 + d4);
        Qs[row * 65 + d4] = q4.x; Qs[row * 65 + d4 + 1] = q4.y; Qs[row * 65 + d4 + 2] = q4.z; Qs[row * 65 + d4 + 3] = q4.w;
      }
    }
    for (int dir = 0; dir < 2; ++dir) {
      const size_t tix = (size_t)((cgk * 4 + head) * 2 + dir);
      int rL = r, hL = h; asm volatile("" : "+v"(rL), "+v"(hL));
      __syncthreads();
      if (!isgla) {
#pragma unroll 2
        for (int i = 0; i < 4; ++i) {
          const int e4 = tid + i * 256, row = e4 >> 4, d4 = (e4 & 15) * 4;
          const float4 k4 = *(const float4*)(CB + (size_t)(T0 + row) * 768 + 256 + head * 64 + d4);
          Ks[row * 65 + d4] = k4.x; Ks[row * 65 + d4 + 1] = k4.y; Ks[row * 65 + d4 + 2] = k4.z; Ks[row * 65 + d4 + 3] = k4.w;
        }
        if (wave == 0) {
          float g = GDEC[(T0 + rmap(dir, lane)) * 8 + dir * 4 + head];
          g = wave_cumsum(g, lane);
          gam[lane] = g;
        }
        __syncthreads();
        {
          f32x16 acc;
#pragma unroll
          for (int e = 0; e < 16; ++e) acc[e] = 0.f;
          if (tj <= ti) {
            const float* ap = Qs + rmap(dir, ti * 32 + r) * 65 + h;
            const float* bp = Ks + rmap(dir, tj * 32 + r) * 65 + h;
#pragma unroll 8
            for (int k2 = 0; k2 < 32; ++k2) acc = __builtin_amdgcn_mfma_f32_32x32x2f32(ap[2 * k2], bp[2 * k2], acc, 0, 0, 0);
          }
          const int sidx = tj * 32 + rL;
          const float gs = gam[sidx];
#pragma unroll
          for (int e = 0; e < 16; ++e) {
            const int tt = ti * 32 + (e & 3) + 8 * (e >> 2) + 4 * hL;
            Att[tt * 65 + sidx] = (sidx <= tt) ? acc[e] * __expf(gam[tt] - gs) : 0.f;
          }
        }
        __syncthreads();
        {
          f32x16 a1, a2;
#pragma unroll
          for (int e = 0; e < 16; ++e) { a1[e] = 0.f; a2[e] = 0.f; }
          float* Sl = Ks;
#pragma unroll
          for (int i = 0; i < 4; ++i) {
            const int e4 = tid + i * 256;
            *(float4*)(Sl + e4 * 4) = *(const float4*)(SDC + tix * 4096 + e4 * 4);
          }
          const float* vp = UW + tix * 12288 + h * 64 + tj * 32 + r;
          float vb[16];
#pragma unroll
          for (int k2 = 0; k2 < 16; ++k2) vb[k2] = vp[2 * k2 * 64];
          __syncthreads();
          const float* ap = Qs + rmap(dir, ti * 32 + r) * 65 + h;
          const float* sp = Sl + h * 64 + tj * 32 + r;
          const float* ap2 = Att + (ti * 32 + r) * 65 + h;
#pragma unroll
          for (int k2 = 0; k2 < 16; ++k2) {
            a1 = __builtin_amdgcn_mfma_f32_32x32x2f32(ap[2 * k2], sp[2 * k2 * 64], a1, 0, 0, 0);
            a2 = __builtin_amdgcn_mfma_f32_32x32x2f32(ap2[2 * k2], vb[k2], a2, 0, 0, 0);
          }
#pragma unroll
          for (int k2 = 0; k2 < 16; ++k2) vb[k2] = vp[2 * (k2 + 16) * 64];
#pragma unroll
          for (int k2 = 16; k2 < 32; ++k2) {
            a1 = __builtin_amdgcn_mfma_f32_32x32x2f32(ap[2 * k2], sp[2 * k2 * 64], a1, 0, 0, 0);
            a2 = __builtin_amdgcn_mfma_f32_32x32x2f32(ap2[2 * k2], vb[k2 - 16], a2, 0, 0, 0);
          }
#pragma unroll
          for (int e = 0; e < 16; ++e) {
            const int tt = ti * 32 + (e & 3) + 8 * (e >> 2) + 4 * hL;
            Ob[rmap(dir, tt) * 65 + tj * 32 + r] += a1[e] * __expf(gam[tt]) + a2[e];
          }
        }
      } else {
        float* segt = gam;
        const int a = tid & 31, seg = tid >> 5;
        float c8[8]; float run = 0.f;
#pragma unroll
        for (int j = 0; j < 8; ++j) {
          run += GLOG[(size_t)(T0 + rmap(dir, seg * 8 + j)) * 256 + dir * 128 + head * 32 + a];
          c8[j] = run;
        }
        segt[seg * 32 + a] = run;
        __syncthreads();
        float off = 0.f;
#pragma unroll
        for (int s2 = 0; s2 < 8; ++s2) { const float v = segt[s2 * 32 + a]; if (s2 < seg) off += v; }
#pragma unroll
        for (int j = 0; j < 8; ++j) {
          const int i = seg * 8 + j;
          const float bb = c8[j] + off;
          const float* zr = Z + (size_t)(T0 + rmap(dir, i)) * PW;
          Qs[i * 33 + a] = zr[768 + head * 32 + a] * 0.17677669529663687f * __expf(bb);
          Ks[i * 33 + a] = zr[896 + head * 32 + a] * __expf(-bb);
        }
        __syncthreads();
        {
          f32x16 acc;
#pragma unroll
          for (int e = 0; e < 16; ++e) acc[e] = 0.f;
          if (tj <= ti) {
            const float* ap = Qs + (ti * 32 + r) * 33 + h;
            const float* bp = Ks + (tj * 32 + r) * 33 + h;
#pragma unroll 8
            for (int k2 = 0; k2 < 16; ++k2) acc = __builtin_amdgcn_mfma_f32_32x32x2f32(ap[2 * k2], bp[2 * k2], acc, 0, 0, 0);
          }
          const int sidx = tj * 32 + rL;
#pragma unroll
          for (int e = 0; e < 16; ++e) {
            const int tt = ti * 32 + (e & 3) + 8 * (e >> 2) + 4 * hL;
            Att[tt * 65 + sidx] = (sidx <= tt) ? acc[e] : 0.f;
          }
        }
        __syncthreads();
        {
          f32x16 a1;
#pragma unroll
          for (int e = 0; e < 16; ++e) a1[e] = 0.f;
          const float* ap = Qs + (ti * 32 + r) * 33 + h;
          const float* sp = SGC + tix * 2048 + h * 64 + tj * 32 + r;
          float sb[16], vb[16];
#pragma unroll
          for (int k2 = 0; k2 < 16; ++k2) sb[k2] = sp[2 * k2 * 64];
#pragma unroll
          for (int k2 = 0; k2 < 16; ++k2) vb[k2] = Z[(size_t)(T0 + rmap(dir, 2 * k2 + h)) * PW + 1024 + head * 64 + tj * 32 + r];
#pragma unroll
          for (int k2 = 0; k2 < 16; ++k2) a1 = __builtin_amdgcn_mfma_f32_32x32x2f32(ap[2 * k2], sb[k2], a1, 0, 0, 0);
          const float* ap2 = Att + (ti * 32 + r) * 65 + h;
#pragma unroll
          for (int k2 = 0; k2 < 16; ++k2) a1 = __builtin_amdgcn_mfma_f32_32x32x2f32(ap2[2 * k2], vb[k2], a1, 0, 0, 0);
#pragma unroll
          for (int k2 = 0; k2 < 16; ++k2) vb[k2] = Z[(size_t)(T0 + rmap(dir, 2 * (k2 + 16) + h)) * PW + 1024 + head * 64 + tj * 32 + r];
#pragma unroll
          for (int k2 = 16; k2 < 32; ++k2) a1 = __builtin_amdgcn_mfma_f32_32x32x2f32(ap2[2 * k2], vb[k2 - 16], a1, 0, 0, 0);
#pragma unroll
          for (int e = 0; e < 16; ++e) {
            const int tt = ti * 32 + (e & 3) + 8 * (e >> 2) + 4 * hL;
            Ob[rmap(dir, tt) * 65 + tj * 32 + r] += a1[e];
          }
        }
      }
    }
    __syncthreads();
    {
      const int row = tid >> 2, part = tid & 3;
      float v[16]; float ss = 0.f;
#pragma unroll
      for (int i = 0; i < 16; ++i) { v[i] = Ob[row * 65 + part * 16 + i]; ss += v[i] * v[i]; }
      ss += __shfl_xor(ss, 1); ss += __shfl_xor(ss, 2);
      const float rstd = rsqrtf(ss * (1.f / 64.f) + EPSF);
      const float* gn = isgla ? (p.in[I_GLAN] + l * 64) : (p.in[I_DELN] + l * 64);
      const float* gz = Z + (size_t)(T0 + row) * PW + (isgla ? 1280 : 2336) + head * 64 + part * 16;
      u16* mo = MIXIN + (size_t)(T0 + row) * 1024 + (isgla ? 512 : 768) + head * 64 + part * 16;
      unsigned o[8];
#pragma unroll
      for (int i = 0; i < 8; ++i) {
        const float y0 = v[2 * i] * rstd * gn[part * 16 + 2 * i] * siluf(gz[2 * i]);
        const float y1 = v[2 * i + 1] * rstd * gn[part * 16 + 2 * i + 1] * siluf(gz[2 * i + 1]);
        o[i] = pk2(y0, y1);
      }
      uint4 o0, o1; o0.x = o[0]; o0.y = o[1]; o0.z = o[2]; o0.w = o[3]; o1.x = o[4]; o1.y = o[5]; o1.z = o[6]; o1.w = o[7];
      *(uint4*)mo = o0; *(uint4*)(mo + 8) = o1;
    }
  }
}

__device__ __forceinline__ void run_phase(const Params& p, int ph, char* smem) {
  if (ph == 0) { phase_mod(p, smem); phase_wconv(p, smem, 0, 0, gridDim.x); return; }
  const int l = (ph - 1) / 10, s = (ph - 1) % 10;
  const u16* H = (const u16*)(p.ws + OFF_H);
  const u16* WT = (const u16*)(p.ws + OFF_WT) + (size_t)l * WT_LAYER;
  if (s == 1) { phase_gemm<0>(H, 1024, WT + WT_IN, nullptr, PW, p.ws + OFF_Z, smem); return; }
  if (s == 6 || s == 9) {
    const u16* A; int K; const u16* W;
    if (s == 6) { A = (const u16*)(p.ws + OFF_MIXIN); K = 1024; W = WT + WT_OUT; }
    else { A = (const u16*)(p.ws + OFF_Z); K = DFF; W = WT + WT_DOWN; }
    phase_gemm<2>(A, K, W, nullptr, 1024, p.ws + OFF_MIX, smem);
    return;
  }
  if (s == 0 || s == 7) { phase_row(p, l, s == 0 ? 0 : 1); return; }
  switch (s) {
    case 2: phase_prep(p, l); break;
    case 3: phase_local(p, l, smem); break;
    case 4: phase_scan_attn(p, l, smem); break;
    case 5: phase_out(p, l, smem); break;
    case 8: phase_gemm<1>(H, 1024, WT + WT_GATE, WT + WT_UP, DFF, p.ws + OFF_Z, smem); break;
  }
}


#define XB_TMO      128
#define XB_XCNT(j)  (256  + 64 * (j))
#define XB_XSUB(j)  (1280 + 64 * (j))
#define XB_XGEN(j)  (2304 + 64 * (j))
#define XB_TOP      3328
#define XB_TOPGEN   3392
#define XCD_BAR_WORDS 3456
#define XB_SPIN_CAP (1u << 22)
__device__ __forceinline__ unsigned xb_ld(unsigned* p)              { return __hip_atomic_load(p, __ATOMIC_RELAXED, __HIP_MEMORY_SCOPE_AGENT); }
__device__ __forceinline__ unsigned xb_add(unsigned* p, unsigned v) { return __hip_atomic_fetch_add(p, v, __ATOMIC_RELAXED, __HIP_MEMORY_SCOPE_AGENT); }
__device__ __forceinline__ unsigned xb_xcc_id() { return (unsigned)__builtin_amdgcn_s_getreg((3 << 11) | 20) & 0xFu; }
#define XB_SPIN(cond, bar) do { unsigned _sp = 0; while (cond) { __builtin_amdgcn_s_sleep(1); \
    if ((++_sp & 255u) == 0u) { if (xb_ld(&(bar)[XB_TMO])) break; if (_sp > XB_SPIN_CAP) { atomicAdd(&(bar)[XB_TMO], 1u); break; } } } } while (0)
struct XcdBarrier { unsigned* bar; unsigned x; volatile LAS unsigned* st; };
__device__ __forceinline__ XcdBarrier xcd_barrier_post(unsigned* bar, volatile LAS unsigned* st) {
    XcdBarrier b; b.bar = bar; b.x = xb_xcc_id(); b.st = st;
    if (threadIdx.x == 0) (void)xb_add(&bar[XB_XCNT(b.x)], 1u);
    return b;
}
__device__ __forceinline__ void xcd_barrier_complete(unsigned* bar, unsigned x, unsigned& nloc, unsigned& nx) {
    const unsigned G = gridDim.x * gridDim.y * gridDim.z;
    unsigned sum, cnt, mine, sp = 0u;
    for (;;) {
        sum = 0u; cnt = 0u; mine = 0u;
#pragma unroll
        for (unsigned j = 0; j < 16; ++j) { const unsigned c = xb_ld(&bar[XB_XCNT(j)]); sum += c; cnt += (c > 0u) ? 1u : 0u; mine = (j == x) ? c : mine; }
        if (sum == G) break;
        __builtin_amdgcn_s_sleep(1);
        if ((++sp & 255u) == 0u) { if (xb_ld(&bar[XB_TMO])) break; if (sp > XB_SPIN_CAP) { atomicAdd(&bar[XB_TMO], 1u); break; } }
    }
    nloc = mine > 0u ? mine : 1u; nx = cnt > 0u ? cnt : 1u;
}
__device__ __forceinline__ void xcd_barrier(const XcdBarrier& b) {
    asm volatile("s_waitcnt vmcnt(0)" ::: "memory");
    __syncthreads();
    if (threadIdx.x == 0) {
        unsigned* bar = b.bar;
        __builtin_amdgcn_s_waitcnt(0);
        unsigned nloc = b.st[0], nx = b.st[1];
        if (nloc == 0u) { xcd_barrier_complete(bar, b.x, nloc, nx); b.st[0] = nloc; b.st[1] = nx; }
        const unsigned old = xb_add(&bar[XB_XSUB(b.x)], 1u);
        const unsigned gen = old / nloc;
        if (old + 1u == (gen + 1u) * nloc) {
            __builtin_amdgcn_fence(__ATOMIC_RELEASE, "agent");
            asm volatile("s_waitcnt vmcnt(0)" ::: "memory");
            const unsigned og = xb_add(&bar[XB_TOP], 1u);
            const unsigned tg = og / nx;
            if (og + 1u == (tg + 1u) * nx) xb_add(&bar[XB_TOPGEN], 1u);
            else XB_SPIN(xb_ld(&bar[XB_TOPGEN]) == tg, bar);
            __builtin_amdgcn_fence(__ATOMIC_ACQUIRE, "agent");
            xb_add(&bar[XB_XGEN(b.x)], 1u);
            asm volatile("s_waitcnt vmcnt(0)" ::: "memory");
        } else {
            XB_SPIN(xb_ld(&bar[XB_XGEN(b.x)]) == gen, bar);
            __builtin_amdgcn_fence(__ATOMIC_ACQUIRE, "agent");
            asm volatile("s_waitcnt vmcnt(0)" ::: "memory");
        }
    }
    __syncthreads();
}

__global__ void __launch_bounds__(256, 2) mega(Params p, int ph_lo, int ph_hi) {
  extern __shared__ __attribute__((aligned(16))) char smem[];
  volatile LAS unsigned* st = (volatile LAS unsigned*)(smem + LDS_BYTES - 16);
  if (threadIdx.x == 0) { st[0] = 0u; st[1] = 0u; }
  __syncthreads();
  XcdBarrier xb = xcd_barrier_post((unsigned*)(p.ws + OFF_BAR), st);
  for (int ph = ph_lo; ph < ph_hi; ++ph) {
    if (ph > ph_lo) xcd_barrier(xb);
#ifdef PROBE_MASK
    const unsigned long long t0 = __builtin_amdgcn_s_memrealtime();
#endif
    run_phase(p, ph, smem);
#ifdef PROBE_MASK
    {
      const int sidx = (ph == 0) ? 10 : (ph - 1) % 10;
      if ((PROBE_MASK >> sidx) & 1) {
        xcd_barrier(xb);
        const unsigned long long t1 = __builtin_amdgcn_s_memrealtime();
        while (__builtin_amdgcn_s_memrealtime() - t1 < t1 - t0) __builtin_amdgcn_s_sleep(8);
      }
    }
#endif
  }
}

extern "C" void kernel_launch(void* const* d_in, const int* in_sizes, int n_in, void* d_out, int out_size, void* d_ws, size_t ws_size,
                              hipStream_t stream) {
  static int grid_blocks = 0;
  if (!grid_blocks) {
    int dev = 0, cus = 0, per_cu = 0;
    hipGetDevice(&dev);
    hipDeviceGetAttribute(&cus, hipDeviceAttributeMultiprocessorCount, dev);
    hipFuncSetAttribute((const void*)mega, hipFuncAttributeMaxDynamicSharedMemorySize, LDS_BYTES);
    hipOccupancyMaxActiveBlocksPerMultiprocessor(&per_cu, (const void*)mega, 256, LDS_BYTES);
    if (per_cu < 1) per_cu = 1;
    if (per_cu > 2) per_cu = 2;
    grid_blocks = cus * per_cu;
    if (ws_size < WS_END) fprintf(stderr, "kernel_launch: workspace too small (%zu < %zu)\n", ws_size, (size_t)WS_END);
  }
  hipMemsetAsync((char*)d_ws + OFF_BAR, 0, 16384, stream);
  Params p{};
  for (int i = 0; i < 24; ++i) p.in[i] = (const float*)d_in[i];
  p.out = (float*)d_out;
  p.ws = (char*)d_ws;
  int lo = 0, hi = 42;
  void* args[] = {&p, &lo, &hi};
  hipError_t e = hipLaunchCooperativeKernel((const void*)mega, dim3(grid_blocks), dim3(256), args, LDS_BYTES, stream);
  if (e != hipSuccess) fprintf(stderr, "cooperative launch failed: %s (grid %d)\n", hipGetErrorString(e), grid_blocks);
}
```

```cpp
#include <hip/hip_runtime.h>
#include <cstdio>

typedef __attribute__((ext_vector_type(8))) short bf16x8;
typedef __attribute__((ext_vector_type(4))) float f32x4;
typedef __attribute__((ext_vector_type(16))) float f32x16;
typedef unsigned short u16;
#define LAS __attribute__((address_space(3)))

#define NT 8192
#define PW 2608
#define DFF 2816
#define EPSF 1e-6f
#define LDS_BYTES 77824

enum { I_XP = 0, I_XS, I_CK, I_CV, I_SG, I_SD, I_C, I_CCTX, I_WMOD, I_BMOD, I_NG, I_WIN, I_QKG, I_WGG, I_BGG,
       I_GLAN, I_CONVW, I_ALOG, I_DTB, I_DELN, I_WOUT, I_WGATE, I_WUP, I_WDOWN };

constexpr size_t O_NCK = 8388608, O_NCV = 10485760, O_NSG = 12582912, O_NSD = 13631488;

constexpr size_t OFF_MODV = 0;
constexpr size_t OFF_H = 524288;
constexpr size_t OFF_MIXIN = OFF_H + (size_t)NT * 1024 * 2;
constexpr size_t OFF_Z = OFF_MIXIN + (size_t)NT * 1024 * 2;
constexpr size_t OFF_QB = OFF_Z + (size_t)NT * PW * 4;
constexpr size_t OFF_KB = OFF_QB + (size_t)NT * 512 * 2;
constexpr size_t OFF_VB = OFF_KB + (size_t)NT * 128 * 2;
constexpr size_t OFF_CB = OFF_VB + (size_t)NT * 128 * 2;
constexpr size_t OFF_GLOG = OFF_CB + (size_t)NT * 768 * 4;
constexpr size_t OFF_BETA = OFF_GLOG + (size_t)NT * 256 * 4;
constexpr size_t OFF_GDEC = OFF_BETA + (size_t)NT * 8 * 4;
constexpr size_t OFF_UW = OFF_GDEC + (size_t)NT * 8 * 4;
constexpr size_t OFF_SDC = OFF_UW + (size_t)1024 * 12288 * 4;
constexpr size_t OFF_SGC = OFF_SDC + (size_t)1024 * 4096 * 4;
constexpr size_t OFF_MIX = OFF_SGC + (size_t)1024 * 2048 * 4;
constexpr size_t OFF_WT = OFF_MIX + (size_t)NT * 1024 * 2;
constexpr size_t WT_IN = 0, WT_OUT = (size_t)PW * 1024, WT_GATE = WT_OUT + (size_t)1024 * 1024, WT_UP = WT_GATE + (size_t)DFF * 1024,
                 WT_DOWN = WT_UP + (size_t)DFF * 1024, WT_LAYER = WT_DOWN + (size_t)1024 * DFF;
constexpr size_t OFF_DG = OFF_WT + 4 * WT_LAYER * 2;
constexpr size_t OFF_EBL = OFF_DG + (size_t)1024 * 2048 * 4;
constexpr size_t OFF_EGL = OFF_EBL + (size_t)1024 * 32 * 4;
constexpr size_t OFF_CKB = OFF_EGL + 4096;
constexpr size_t OFF_CVB = OFF_CKB + (size_t)4 * 65536 * 2;
constexpr size_t OFF_BAR = OFF_CVB + (size_t)4 * 65536 * 2;
constexpr size_t WS_END = OFF_BAR + 16384;

struct Params {
  const float* in[24];
  float* out;
  char* ws;
};

__device__ __forceinline__ unsigned f2bf(float f) { unsigned u = __float_as_uint(f); return (u + 0x7fffu + ((u >> 16) & 1u)) >> 16; }
typedef __bf16 bf16x2_t __attribute__((ext_vector_type(2)));
typedef float float2_t __attribute__((ext_vector_type(2)));
__device__ __forceinline__ unsigned pk2(float lo, float hi) { float2_t f = {lo, hi}; bf16x2_t r = __builtin_convertvector(f, bf16x2_t); return __builtin_bit_cast(unsigned, r); }
__device__ __forceinline__ float wave_sum(float v) {
#pragma unroll
  for (int o = 32; o; o >>= 1) v += __shfl_xor(v, o);
  return v;
}
__device__ __forceinline__ float siluf(float x) { return x / (1.f + __expf(-x)); }
__device__ __forceinline__ float sigmf(float x) { return 1.f / (1.f + __expf(-x)); }
__device__ __forceinline__ float softplusf(float x) { return x > 20.f ? x : __logf(1.f + __expf(x)); }
__device__ __forceinline__ int rmap(int dir, int i) { return dir ? 63 - i : i; }
__device__ __forceinline__ float wave_cumsum(float v, int lane) {
#pragma unroll
  for (int o = 1; o < 64; o <<= 1) { float t = __shfl_up(v, o); if (lane >= o) v += t; }
  return v;
}

__device__ __forceinline__ int ltid() { int v = threadIdx.x; asm volatile("" : "+v"(v)); return v; }
__device__ __forceinline__ int lbid() { int v = blockIdx.x; asm volatile("" : "+s"(v)); return v; }

__device__ __forceinline__ void phase_mod(const Params& p, char* smem) {
  float* sc = (float*)smem;
  float* red = sc + 5 * 1024;
  const int tid = ltid();
  for (int i = tid; i < 5 * 1024; i += 256) {
    int m = i >> 10, k = i & 1023;
    float c = (m == 0) ? p.in[I_CCTX][k] : p.in[I_C][(m - 1) * 1024 + k];
    sc[i] = siluf(c);
  }
  __syncthreads();
  float* modv = (float*)(p.ws + OFF_MODV);
  const int col = tid & 63, kg = tid >> 6;
  for (int t = lbid(); t < 384; t += gridDim.x) {
    const int l = t / 96, n0 = (t % 96) * 64;
    const float* w = p.in[I_WMOD] + (size_t)l * 1024 * 6144 + (size_t)(kg * 256) * 6144 + n0 + col;
    float a0 = 0.f, a1 = 0.f, a2 = 0.f, a3 = 0.f, a4 = 0.f;
#pragma unroll 16
    for (int k = 0; k < 256; ++k) {
      float wv = w[(size_t)k * 6144];
      int kk = kg * 256 + k;
      a0 += sc[kk] * wv; a1 += sc[1024 + kk] * wv; a2 += sc[2048 + kk] * wv; a3 += sc[3072 + kk] * wv; a4 += sc[4096 + kk] * wv;
    }
    red[(kg * 5 + 0) * 64 + col] = a0; red[(kg * 5 + 1) * 64 + col] = a1; red[(kg * 5 + 2) * 64 + col] = a2;
    red[(kg * 5 + 3) * 64 + col] = a3; red[(kg * 5 + 4) * 64 + col] = a4;
    __syncthreads();
    if (tid < 64) {
      float bb = p.in[I_BMOD][l * 6144 + n0 + col];
#pragma unroll
      for (int m = 0; m < 5; ++m) {
        float s = red[(0 * 5 + m) * 64 + col] + red[(1 * 5 + m) * 64 + col] + red[(2 * 5 + m) * 64 + col] + red[(3 * 5 + m) * 64 + col];
        modv[(size_t)(l * 5 + m) * 6144 + n0 + col] = s + bb;
      }
    }
    __syncthreads();
  }
}

__device__ __forceinline__ void phase_wconv(const Params& p, char* smem, int l, int b0, int nb) {
  float* tile = (float*)smem;
  const int tid = ltid();
  u16* WT = (u16*)(p.ws + OFF_WT);
  const int c0 = 16 * 41, c1 = c0 + 256, c2 = c1 + 704, c3 = c2 + 704, c4 = c3 + 704;
  for (int t = lbid() - b0; t < c4; t += nb) {
    int u = t;
    const float* W; u16* O; int K, N, tk, tn;
    if (u < c0) { W = p.in[I_WIN] + (size_t)l * 1024 * PW; O = WT + l * WT_LAYER + WT_IN; K = 1024; N = PW; tk = u & 15; tn = u >> 4; }
    else if (u < c1) { u -= c0; W = p.in[I_WOUT] + (size_t)l * 1024 * 1024; O = WT + l * WT_LAYER + WT_OUT; K = 1024; N = 1024; tk = u & 15; tn = u >> 4; }
    else if (u < c2) { u -= c1; W = p.in[I_WGATE] + (size_t)l * 1024 * DFF; O = WT + l * WT_LAYER + WT_GATE; K = 1024; N = DFF; tk = u & 15; tn = u >> 4; }
    else if (u < c3) { u -= c2; W = p.in[I_WUP] + (size_t)l * 1024 * DFF; O = WT + l * WT_LAYER + WT_UP; K = 1024; N = DFF; tk = u & 15; tn = u >> 4; }
    else { u -= c3; W = p.in[I_WDOWN] + (size_t)l * DFF * 1024; O = WT + l * WT_LAYER + WT_DOWN; K = DFF; N = 1024; tk = u % 44; tn = u / 44; }
    const int k0 = tk * 64, n0 = tn * 64;
    __syncthreads();
    float wv[16];
#pragma unroll
    for (int i = 0; i < 16; ++i) {
      const int e = tid + i * 256, kk = e >> 6, nn = e & 63;
      int col = n0 + nn; if (col > N - 1) col = N - 1;
      wv[i] = W[(size_t)(k0 + kk) * N + col];
    }
#pragma unroll
    for (int i = 0; i < 16; ++i) {
      const int e = tid + i * 256, kk = e >> 6, nn = e & 63;
      tile[kk * 65 + nn] = wv[i];
    }
    __syncthreads();
#pragma unroll
    for (int i = 0; i < 8; ++i) {
      const int e = tid + i * 256, nn = e >> 5, kp = e & 31;
      if (n0 + nn < N) *(unsigned*)(O + (size_t)(n0 + nn) * K + k0 + 2 * kp) = pk2(tile[(2 * kp) * 65 + nn], tile[(2 * kp + 1) * 65 + nn]);
    }
  }
}

__device__ __forceinline__ void phase_row(const Params& p, int l, int mode) {
  const int lane = ltid() & 63, wave = ltid() >> 6;
  float* X = p.out;
  const u16* MIX = (const u16*)(p.ws + OFF_MIX);
  u16* H = (u16*)(p.ws + OFF_H);
  const float* modv = (const float*)(p.ws + OFF_MODV);
  const float* ng = p.in[I_NG];
  const bool first = (mode == 0 && l == 0);
  const int bx = lbid() & 7, by = lbid() >> 3, wpx = (int)(gridDim.x >> 3) * 4;
  const bool xmap = (gridDim.x & 7) == 0;
  const int nit = xmap ? 1024 : NT, it0 = xmap ? by * 4 + wave : lbid() * 4 + wave, its = xmap ? wpx : (int)gridDim.x * 4;
  for (int idx = it0; idx < nit; idx += its) {
    const int row = xmap ? (bx + 8 * (idx >> 7)) * 128 + (idx & 127) : idx;
    const int m = row < 4096 ? 0 : 1 + ((row - 4096) >> 10);
    const float* xsrc = first ? (row < 4096 ? p.in[I_XP] + (size_t)row * 1024 : p.in[I_XS] + (size_t)(row - 4096) * 1024)
                              : X + (size_t)row * 1024;
    const bool donorm = (mode == 1 || l < 4);
    float4 xv[4], yv4[4], ga4[4], gt4[4], gb4[4], sc4[4], sh4[4];
#pragma unroll
    for (int i = 0; i < 4; ++i) xv[i] = *(const float4*)(xsrc + i * 256 + lane * 4);
    if (!first) {
      const u16* y = MIX + (size_t)row * 1024;
      const float* ga; const float* gate;
      if (mode == 0) { ga = ng + ((l - 1) * 4 + 3) * 1024; gate = modv + (size_t)((l - 1) * 5 + m) * 6144 + 5 * 1024; }
      else { ga = ng + (l * 4 + 1) * 1024; gate = modv + (size_t)(l * 5 + m) * 6144 + 2 * 1024; }
#pragma unroll
      for (int i = 0; i < 4; ++i) {
        { const uint2 yb = *(const uint2*)(y + i * 256 + lane * 4);
          yv4[i].x = __uint_as_float(yb.x << 16); yv4[i].y = __uint_as_float(yb.x & 0xffff0000u);
          yv4[i].z = __uint_as_float(yb.y << 16); yv4[i].w = __uint_as_float(yb.y & 0xffff0000u); }
        ga4[i] = *(const float4*)(ga + i * 256 + lane * 4);
        gt4[i] = *(const float4*)(gate + i * 256 + lane * 4);
      }
    }
    if (donorm) {
      const float* gb = ng + (l * 4 + (mode == 0 ? 0 : 2)) * 1024;
      const float* scale = modv + (size_t)(l * 5 + m) * 6144 + (mode == 0 ? 1 : 4) * 1024;
      const float* shift = modv + (size_t)(l * 5 + m) * 6144 + (mode == 0 ? 0 : 3) * 1024;
#pragma unroll
      for (int i = 0; i < 4; ++i) {
        gb4[i] = *(const float4*)(gb + i * 256 + lane * 4);
        sc4[i] = *(const float4*)(scale + i * 256 + lane * 4);
        sh4[i] = *(const float4*)(shift + i * 256 + lane * 4);
      }
    }
    if (!first) {
      float ss = 0.f;
#pragma unroll
      for (int i = 0; i < 4; ++i) ss += yv4[i].x * yv4[i].x + yv4[i].y * yv4[i].y + yv4[i].z * yv4[i].z + yv4[i].w * yv4[i].w;
      ss = wave_sum(ss);
      const float rstd = rsqrtf(ss * (1.f / 1024.f) + EPSF);
#pragma unroll
      for (int i = 0; i < 4; ++i) {
        xv[i].x += gt4[i].x * (yv4[i].x * rstd * ga4[i].x);
        xv[i].y += gt4[i].y * (yv4[i].y * rstd * ga4[i].y);
        xv[i].z += gt4[i].z * (yv4[i].z * rstd * ga4[i].z);
        xv[i].w += gt4[i].w * (yv4[i].w * rstd * ga4[i].w);
      }
    }
#pragma unroll
    for (int i = 0; i < 4; ++i) *(float4*)(X + (size_t)row * 1024 + i * 256 + lane * 4) = xv[i];
    if (donorm) {
      float ss = 0.f;
#pragma unroll
      for (int i = 0; i < 4; ++i) ss += xv[i].x * xv[i].x + xv[i].y * xv[i].y + xv[i].z * xv[i].z + xv[i].w * xv[i].w;
      ss = wave_sum(ss);
      const float rstd = rsqrtf(ss * (1.f / 1024.f) + EPSF);
#pragma unroll
      for (int i = 0; i < 4; ++i) {
        const float h0 = xv[i].x * rstd * gb4[i].x * (1.f + sc4[i].x) + sh4[i].x;
        const float h1 = xv[i].y * rstd * gb4[i].y * (1.f + sc4[i].y) + sh4[i].y;
        const float h2 = xv[i].z * rstd * gb4[i].z * (1.f + sc4[i].z) + sh4[i].z;
        const float h3 = xv[i].w * rstd * gb4[i].w * (1.f + sc4[i].w) + sh4[i].w;
        uint2 o; o.x = pk2(h0, h1); o.y = pk2(h2, h3);
        *(uint2*)(H + (size_t)row * 1024 + i * 256 + lane * 4) = o;
      }
    }
  }
}

#define GBK 64
template <int EPI>
__device__ __forceinline__ void phase_gemm(const u16* __restrict__ A, int K, const u16* __restrict__ W0, const u16* __restrict__ W1, int N,
                           void* outp, char* smem) {
  char* sA = smem;
  char* sB = smem + 2 * 16384;
  const int tid = ltid(), lane = tid & 63, wave = tid >> 6, r = lane & 31, h = lane >> 5;
  const int wm = wave >> 1, wn = wave & 1;
  const int ntn = (EPI != 1) ? (N + 127) / 128 : N / 64;
  const int ntiles = 64 * ntn;
  const int nk = K / GBK;
  const int srow = wave * 8 + (lane >> 3);
  const int sk = ((lane & 7) ^ ((wave * 4 + (lane >> 4)) & 7)) * 8;
  const int fsw = (r >> 1) & 7;
  for (int t = lbid(); t < ntiles; t += gridDim.x) {
    const int tm = t & 63, tn = t >> 6;
    const int m0 = tm * 128;
    const u16* ap = A + (size_t)(m0 + srow) * K + sk;
    const u16* bp[4];
#pragma unroll
    for (int i = 0; i < 4; ++i) {
      const int nl = srow + 32 * i;
      if (EPI != 1) { int col = tn * 128 + nl; if (col > N - 1) col = N - 1; bp[i] = W0 + (size_t)col * K + sk; }
      else { bp[i] = (nl < 64) ? (W0 + (size_t)(tn * 64 + nl) * K + sk) : (W1 + (size_t)(tn * 64 + nl - 64) * K + sk); }
    }
    f32x16 acc[2][2];
#pragma unroll
    for (int i = 0; i < 2; ++i)
#pragma unroll
      for (int j = 0; j < 2; ++j)
#pragma unroll
        for (int e = 0; e < 16; ++e) acc[i][j][e] = 0.f;
#define GSTAGE(buf, kt) do { _Pragma("unroll") for (int i = 0; i < 4; ++i) { \
      __builtin_amdgcn_global_load_lds((const unsigned*)(ap + (size_t)(32 * i) * K + (kt) * GBK), (LAS unsigned*)(sA + (buf) * 16384 + (i * 32 + wave * 8) * 128), 16, 0, 0); \
      __builtin_amdgcn_global_load_lds((const unsigned*)(bp[i] + (kt) * GBK), (LAS unsigned*)(sB + (buf) * 16384 + (i * 32 + wave * 8) * 128), 16, 0, 0); } } while (0)
    GSTAGE(0, 0);
    asm volatile("s_waitcnt vmcnt(0)" ::: "memory");
    __syncthreads();
    for (int kt = 0; kt < nk; ++kt) {
      if (kt + 1 < nk) GSTAGE((kt + 1) & 1, kt + 1);
      const char* cA = sA + (kt & 1) * 16384;
      const char* cB = sB + (kt & 1) * 16384;
#pragma unroll
      for (int ks = 0; ks < 4; ++ks) {
        bf16x8 af[2], bfr[2];
        const int pos = ((ks * 2 + h) ^ fsw) * 16;
#pragma unroll
        for (int i = 0; i < 2; ++i) af[i] = *(const bf16x8*)(cA + (wm * 64 + i * 32 + r) * 128 + pos);
#pragma unroll
        for (int j = 0; j < 2; ++j) bfr[j] = *(const bf16x8*)(cB + (j * 64 + wn * 32 + r) * 128 + pos);
#pragma unroll
        for (int i = 0; i < 2; ++i)
#pragma unroll
          for (int j = 0; j < 2; ++j) acc[i][j] = __builtin_amdgcn_mfma_f32_32x32x16_bf16(af[i], bfr[j], acc[i][j], 0, 0, 0);
      }
      asm volatile("s_waitcnt vmcnt(0)" ::: "memory");
      __syncthreads();
    }
#undef GSTAGE
    if (EPI == 0) {
      float* C = (float*)outp;
#pragma unroll
      for (int i = 0; i < 2; ++i)
#pragma unroll
        for (int j = 0; j < 2; ++j) {
          const int col = tn * 128 + j * 64 + wn * 32 + r;
          if (col < N) {
#pragma unroll
            for (int e = 0; e < 16; ++e) {
              const int row = m0 + wm * 64 + i * 32 + (e & 3) + 8 * (e >> 2) + 4 * h;
              __hip_atomic_store(&C[(size_t)row * N + col], acc[i][j][e], __ATOMIC_RELAXED, __HIP_MEMORY_SCOPE_AGENT);
            }
          }
        }
    } else if (EPI == 2) {
      u16* C = (u16*)outp;
#pragma unroll
      for (int i = 0; i < 2; ++i)
#pragma unroll
        for (int j = 0; j < 2; ++j) {
          const int col = tn * 128 + j * 64 + wn * 32 + r;
#pragma unroll
          for (int e = 0; e < 16; ++e) {
            const int row = m0 + wm * 64 + i * 32 + (e & 3) + 8 * (e >> 2) + 4 * h;
            C[(size_t)row * N + col] = (u16)f2bf(acc[i][j][e]);
          }
        }
    } else {
      u16* C = (u16*)outp;
#pragma unroll
      for (int i = 0; i < 2; ++i) {
        const int col = tn * 64 + wn * 32 + r;
#pragma unroll
        for (int e = 0; e < 16; ++e) {
          const int row = m0 + wm * 64 + i * 32 + (e & 3) + 8 * (e >> 2) + 4 * h;
          const float g = acc[i][0][e], u = acc[i][1][e];
          C[(size_t)row * N + col] = (u16)f2bf(siluf(g) * u);
        }
      }
    }
  }
}

__device__ __forceinline__ void phase_prep(const Params& p, int l) {
  const int lane = ltid() & 63, wave = ltid() >> 6;
  const float* Z = (const float*)(p.ws + OFF_Z);
  u16* QB = (u16*)(p.ws + OFF_QB); u16* KB = (u16*)(p.ws + OFF_KB); u16* VB = (u16*)(p.ws + OFF_VB);
  float* CB = (float*)(p.ws + OFF_CB); float* GLOG = (float*)(p.ws + OFF_GLOG);
  float* BETA = (float*)(p.ws + OFF_BETA); float* GDEC = (float*)(p.ws + OFF_GDEC);
  const float* qkg = p.in[I_QKG] + l * 128;
  const float* convw = p.in[I_CONVW] + l * 5 * 768;
  const float* wgg = p.in[I_WGG] + l * 2 * 16 * 128;
  const float* bgg = p.in[I_BGG] + l * 256;
  const float LOG2_THETA_16 = 13.287712379549449f / 16.f;
  const int bx = lbid() & 7, by = lbid() >> 3, wpx = (int)(gridDim.x >> 3) * 4;
  const bool xmap = (gridDim.x & 7) == 0;
  const int nit = xmap ? 1024 : NT, it0 = xmap ? by * 4 + wave : lbid() * 4 + wave, its = xmap ? wpx : (int)gridDim.x * 4;
  for (int idx = it0; idx < nit; idx += its) {
    const int t = xmap ? (bx + 8 * (idx >> 7)) * 128 + (idx & 127) : idx;
    const bool lat = t >= 4096;
    const int b = lat ? (t - 4096) >> 10 : t >> 8;
    const int s = lat ? (t - 4096) & 1023 : t & 255;
    const int slen = lat ? 1024 : 256;
    const float* zr = Z + (size_t)t * PW;
    const float prow = (float)(s >> 6), pcol = (float)(s & 63);
    {
      const int head = lane >> 3, sub = lane & 7;
      float v[4][2]; float ss = 0.f;
#pragma unroll
      for (int q = 0; q < 4; ++q) {
        float2 f = *(const float2*)(zr + head * 64 + q * 16 + sub * 2);
        v[q][0] = f.x; v[q][1] = f.y; ss += f.x * f.x + f.y * f.y;
      }
      ss += __shfl_xor(ss, 1); ss += __shfl_xor(ss, 2); ss += __shfl_xor(ss, 4);
      const float rstd = rsqrtf(ss * (1.f / 64.f) + EPSF);
#pragma unroll
      for (int q = 0; q < 4; ++q)
#pragma unroll
        for (int i = 0; i < 2; ++i) v[q][i] *= rstd * qkg[q * 16 + sub * 2 + i];
      if (lat) {
#pragma unroll
        for (int i = 0; i < 2; ++i) {
          const float inv = exp2f(-(float)(sub * 2 + i) * LOG2_THETA_16);
          const float ar = prow * inv, ac = pcol * inv;
          const float cr = __cosf(ar), sr = __sinf(ar), cc = __cosf(ac), sn = __sinf(ac);
          const float a1 = v[0][i], a2 = v[1][i], b1 = v[2][i], b2 = v[3][i];
          v[0][i] = a1 * cr - a2 * sr; v[1][i] = a2 * cr + a1 * sr;
          v[2][i] = b1 * cc - b2 * sn; v[3][i] = b2 * cc + b1 * sn;
        }
      }
#pragma unroll
      for (int q = 0; q < 4; ++q) *(unsigned*)(QB + (size_t)t * 512 + head * 64 + q * 16 + sub * 2) = pk2(v[q][0], v[q][1]);
    }
    {
      const int g = lane >> 5, j = lane & 31;
      const int d0 = j + (j >= 16 ? 16 : 0), d1 = d0 + 16;
      float v0 = zr[512 + g * 64 + d0], v1 = zr[512 + g * 64 + d1];
      float ss = v0 * v0 + v1 * v1;
      ss += __shfl_xor(ss, 1); ss += __shfl_xor(ss, 2); ss += __shfl_xor(ss, 4); ss += __shfl_xor(ss, 8); ss += __shfl_xor(ss, 16);
      const float rstd = rsqrtf(ss * (1.f / 64.f) + EPSF);
      v0 *= rstd * qkg[64 + d0]; v1 *= rstd * qkg[64 + d1];
      if (!lat) {
        float* nk = p.out + O_NCK + ((size_t)(b * 4 + l) * 256 + s) * 128 + g * 64;
        nk[d0] = v0; nk[d1] = v1;
      } else {
        const float inv = exp2f(-(float)(j & 15) * LOG2_THETA_16);
        const float ang = (j < 16 ? prow : pcol) * inv;
        const float c = __cosf(ang), sn = __sinf(ang);
        const float y0 = v0 * c - v1 * sn, y1 = v1 * c + v0 * sn;
        v0 = y0; v1 = y1;
      }
      KB[(size_t)t * 128 + g * 64 + d0] = (u16)f2bf(v0);
      KB[(size_t)t * 128 + g * 64 + d1] = (u16)f2bf(v1);
    }
    {
      float2 f = *(const float2*)(zr + 640 + lane * 2);
      if (!lat) *(float2*)(p.out + O_NCV + ((size_t)(b * 4 + l) * 256 + s) * 128 + lane * 2) = f;
      *(unsigned*)(VB + (size_t)t * 128 + lane * 2) = pk2(f.x, f.y);
    }
    {
#pragma unroll
      for (int it = 0; it < 3; ++it) {
        const int c4 = (it * 64 + lane) * 4;
        float4 acc; acc.x = 0.f; acc.y = 0.f; acc.z = 0.f; acc.w = 0.f;
#pragma unroll
        for (int j = 0; j < 5; ++j) {
          const int sj = s + j - 2;
          if (sj >= 0 && sj < slen) {
            const float4 zv = *(const float4*)(Z + (size_t)(t + j - 2) * PW + 1568 + c4);
            const float4 wv = *(const float4*)(convw + j * 768 + c4);
            acc.x += zv.x * wv.x; acc.y += zv.y * wv.y; acc.z += zv.z * wv.z; acc.w += zv.w * wv.w;
          }
        }
        acc.x = siluf(acc.x); acc.y = siluf(acc.y); acc.z = siluf(acc.z); acc.w = siluf(acc.w);
        if (it < 2) {
          float ss = acc.x * acc.x + acc.y * acc.y + acc.z * acc.z + acc.w * acc.w;
          ss += __shfl_xor(ss, 1); ss += __shfl_xor(ss, 2); ss += __shfl_xor(ss, 4); ss += __shfl_xor(ss, 8);
          const float sc = rsqrtf(ss + EPSF) * (it == 0 ? 0.125f : 1.f);
          acc.x *= sc; acc.y *= sc; acc.z *= sc; acc.w *= sc;
        }
        *(float4*)(CB + (size_t)t * 768 + c4) = acc;
      }
    }
    {
      const int dir = lane >> 5, k4 = (lane & 31) * 4;
      float gc[16];
#pragma unroll
      for (int i = 0; i < 4; ++i) {
        const float4 g4 = *(const float4*)(zr + 1536 + dir * 16 + i * 4);
        gc[i * 4] = g4.x; gc[i * 4 + 1] = g4.y; gc[i * 4 + 2] = g4.z; gc[i * 4 + 3] = g4.w;
      }
      float4 acc = *(const float4*)(bgg + dir * 128 + k4);
#pragma unroll
      for (int rr = 0; rr < 16; ++rr) {
        const float4 w4 = *(const float4*)(wgg + (dir * 16 + rr) * 128 + k4);
        acc.x += gc[rr] * w4.x; acc.y += gc[rr] * w4.y; acc.z += gc[rr] * w4.z; acc.w += gc[rr] * w4.w;
      }
      float4 o;
      o.x = -softplusf(-acc.x) * (1.f / 16.f); o.y = -softplusf(-acc.y) * (1.f / 16.f);
      o.z = -softplusf(-acc.z) * (1.f / 16.f); o.w = -softplusf(-acc.w) * (1.f / 16.f);
      *(float4*)(GLOG + (size_t)t * 256 + dir * 128 + k4) = o;
    }
    if (lane < 8) BETA[t * 8 + lane] = sigmf(zr[2592 + lane]);
    else if (lane < 16) {
      const int i = lane - 8;
      GDEC[t * 8 + i] = -__expf(p.in[I_ALOG][l * 8 + i]) * softplusf(zr[2600 + i] + p.in[I_DTB][l * 8 + i]);
    }
  }
  {
    u16* CKB = (u16*)(p.ws + OFF_CKB); u16* CVB = (u16*)(p.ws + OFF_CVB);
    for (int i = lbid() * 256 + ltid(); i < 4 * 8192; i += gridDim.x * 256) {
      const int b = i >> 13, off = (i & 8191) * 8;
      const float* ks = p.in[I_CK] + (size_t)(b * 4 + l) * 65536 + off;
      const float* vs = p.in[I_CV] + (size_t)(b * 4 + l) * 65536 + off;
      const float4 k0 = *(const float4*)ks, k1 = *(const float4*)(ks + 4), v0 = *(const float4*)vs, v1 = *(const float4*)(vs + 4);
      uint4 ko, vo;
      ko.x = pk2(k0.x, k0.y); ko.y = pk2(k0.z, k0.w); ko.z = pk2(k1.x, k1.y); ko.w = pk2(k1.z, k1.w);
      vo.x = pk2(v0.x, v0.y); vo.y = pk2(v0.z, v0.w); vo.z = pk2(v1.x, v1.y); vo.w = pk2(v1.z, v1.w);
      *(uint4*)(CKB + (size_t)b * 65536 + off) = ko;
      *(uint4*)(CVB + (size_t)b * 65536 + off) = vo;
    }
  }
}

__device__ __forceinline__ void phase_local(const Params& p, int l, char* smem) {
  const int tid = ltid(), lane = tid & 63, wave = tid >> 6, r = lane & 31, h = lane >> 5, c16 = lane & 15, q = lane >> 4;
  const float* CB = (const float*)(p.ws + OFF_CB);
  const float* BETA = (const float*)(p.ws + OFF_BETA); const float* GDEC = (const float*)(p.ws + OFF_GDEC);
  const float* Z = (const float*)(p.ws + OFF_Z);
  const float* GLOG = (const float*)(p.ws + OFF_GLOG);
  float* UW = (float*)(p.ws + OFF_UW);
  float* EGL = (float*)(p.ws + OFF_EGL);
  float* DG = (float*)(p.ws + OFF_DG);
  float* EBL = (float*)(p.ws + OFF_EBL);
  for (int task = lbid(); task < 2048; task += gridDim.x) {
    const int tk = task & 1023;
    const int dir = tk & 1, head = (tk >> 1) & 3, cgk = tk >> 3;
    const int T0 = cgk * 64;
    __syncthreads();
    if (task < 1024) {
      float* Kc = (float*)smem;
      float* Mm = Kc + 64 * 65;
      float* X = Mm + 64 * 68;
      float* gam = X + 64 * 128;
      float* bet = gam + 64;
      float* eg = bet + 64;
#pragma unroll
      for (int i = 0; i < 4; ++i) {
        const int e4 = tid + i * 256, row = e4 >> 4, d4 = (e4 & 15) * 4;
        const float4 kv4 = *(const float4*)(CB + (size_t)(T0 + row) * 768 + 256 + head * 64 + d4);
        Kc[row * 65 + d4] = kv4.x; Kc[row * 65 + d4 + 1] = kv4.y; Kc[row * 65 + d4 + 2] = kv4.z; Kc[row * 65 + d4 + 3] = kv4.w;
      }
      if (wave == 0) {
        const int tr = T0 + rmap(dir, lane);
        float g = GDEC[tr * 8 + dir * 4 + head];
        g = wave_cumsum(g, lane);
        gam[lane] = g;
        eg[lane] = __expf(g);
        bet[lane] = BETA[tr * 8 + dir * 4 + head];
      }
      __syncthreads();
      {
        const int ti = wave >> 1, tj = wave & 1;
        f32x16 acc;
#pragma unroll
        for (int e = 0; e < 16; ++e) acc[e] = 0.f;
        if (tj <= ti) {
          const float* ap = Kc + rmap(dir, ti * 32 + r) * 65 + h;
          const float* bp = Kc + rmap(dir, tj * 32 + r) * 65 + h;
#pragma unroll 8
          for (int k2 = 0; k2 < 32; ++k2) acc = __builtin_amdgcn_mfma_f32_32x32x2f32(ap[2 * k2], bp[2 * k2], acc, 0, 0, 0);
        }
        const int sidx = tj * 32 + r;
        const float gs = gam[sidx];
#pragma unroll
        for (int e = 0; e < 16; ++e) {
          const int tt = ti * 32 + (e & 3) + 8 * (e >> 2) + 4 * h;
          float v = 0.f;
          if (sidx < tt) v = acc[e] * bet[tt] * __expf(gam[tt] - gs);
          Mm[tt * 68 + sidx] = v;
        }
      }
      float* o = UW + (size_t)tk * 12288;
      const float gl = gam[63];
#pragma unroll
      for (int i = 0; i < 4; ++i) {
        const int e4 = tid + i * 256, tt = e4 >> 4, d4 = (e4 & 15) * 4;
        const int rr = rmap(dir, tt);
        const float bt = bet[tt], egt = eg[tt];
        const float4 vv = *(const float4*)(CB + (size_t)(T0 + rr) * 768 + 512 + head * 64 + d4);
        float4 xu; xu.x = vv.x * bt; xu.y = vv.y * bt; xu.z = vv.z * bt; xu.w = vv.w * bt;
        *(float4*)(X + tt * 128 + d4) = xu;
        const float k0 = Kc[rr * 65 + d4], k1 = Kc[rr * 65 + d4 + 1], k2 = Kc[rr * 65 + d4 + 2], k3 = Kc[rr * 65 + d4 + 3];
        float4 xw; xw.x = k0 * egt * bt; xw.y = k1 * egt * bt; xw.z = k2 * egt * bt; xw.w = k3 * egt * bt;
        *(float4*)(X + tt * 128 + 64 + d4) = xw;
      }
      {
        u16* khh = (u16*)(o + 8192); u16* khl = khh + 4096;
#pragma unroll 2
        for (int it = 0; it < 8; ++it) {
          const int idx = tid + it * 256, a = idx >> 5, i0 = (idx & 31) * 2;
          const float v0 = Kc[rmap(dir, i0) * 65 + a] * __expf(gl - gam[i0]);
          const float v1 = Kc[rmap(dir, i0 + 1) * 65 + a] * __expf(gl - gam[i0 + 1]);
          const unsigned h0 = f2bf(v0), h1 = f2bf(v1);
          const unsigned l0 = f2bf(v0 - __uint_as_float(h0 << 16)), l1 = f2bf(v1 - __uint_as_float(h1 << 16));
          *(unsigned*)(khh + a * 64 + i0) = h0 | (h1 << 16);
          *(unsigned*)(khl + a * 64 + i0) = l0 | (l1 << 16);
        }
      }
      if (tid == 0) EGL[tk] = __expf(gl);
      __syncthreads();
#pragma unroll 1
      for (int bk = 0; bk < 4; ++bk) {
        if (tid < 128) {
          float x[16];
#pragma unroll
          for (int t2 = 0; t2 < 16; ++t2) {
            float a = X[(16 * bk + t2) * 128 + tid];
#pragma unroll
            for (int s2 = 0; s2 < t2; ++s2) a -= Mm[(16 * bk + t2) * 68 + 16 * bk + s2] * x[s2];
            x[t2] = a;
          }
#pragma unroll
          for (int t2 = 0; t2 < 16; ++t2) X[(16 * bk + t2) * 128 + tid] = x[t2];
        }
        __syncthreads();
        const int ntile = (3 - bk) * 8;
        for (int tl = wave; tl < ntile; tl += 4) {
          const int rt = bk + 1 + (tl >> 3), ct = tl & 7;
          f32x4 c;
#pragma unroll
          for (int e = 0; e < 4; ++e) c[e] = X[(rt * 16 + 4 * q + e) * 128 + ct * 16 + c16];
#pragma unroll
          for (int ks = 0; ks < 4; ++ks)
            c = __builtin_amdgcn_mfma_f32_16x16x4f32(-Mm[(rt * 16 + c16) * 68 + 16 * bk + 4 * ks + q], X[(16 * bk + 4 * ks + q) * 128 + ct * 16 + c16], c, 0, 0, 0);
#pragma unroll
          for (int e = 0; e < 4; ++e) X[(rt * 16 + 4 * q + e) * 128 + ct * 16 + c16] = c[e];
        }
        __syncthreads();
      }
#pragma unroll
      for (int i = 0; i < 8; ++i) {
        const int e4 = tid + i * 256, tt = e4 >> 5, j4 = (e4 & 31) * 4;
        const float4 xv = *(const float4*)(X + tt * 128 + j4);
        if (j4 < 64) *(float4*)(o + tt * 64 + j4) = xv;
        else {
          u16* wh = (u16*)(o + 4096); u16* wl = wh + 4096;
          const unsigned h0 = f2bf(xv.x), h1 = f2bf(xv.y), h2 = f2bf(xv.z), h3 = f2bf(xv.w);
          uint2 hv, lv;
          hv.x = h0 | (h1 << 16); hv.y = h2 | (h3 << 16);
          lv.x = f2bf(xv.x - __uint_as_float(h0 << 16)) | (f2bf(xv.y - __uint_as_float(h1 << 16)) << 16);
          lv.y = f2bf(xv.z - __uint_as_float(h2 << 16)) | (f2bf(xv.w - __uint_as_float(h3 << 16)) << 16);
          *(uint2*)(wh + tt * 64 + (j4 - 64)) = hv;
          *(uint2*)(wl + tt * 64 + (j4 - 64)) = lv;
        }
      }
    } else {
      float* Kh = (float*)smem;
      float* segt = Kh + 64 * 33;
      const int a = tid & 31, seg = tid >> 5;
      float c8[8]; float run = 0.f;
#pragma unroll
      for (int j = 0; j < 8; ++j) {
        run += GLOG[(size_t)(T0 + rmap(dir, seg * 8 + j)) * 256 + dir * 128 + head * 32 + a];
        c8[j] = run;
      }
      float kv[8];
#pragma unroll
      for (int j = 0; j < 8; ++j) kv[j] = Z[(size_t)(T0 + rmap(dir, seg * 8 + j)) * PW + 896 + head * 32 + a];
      segt[seg * 32 + a] = run;
      __syncthreads();
      float off = 0.f, tot = 0.f;
#pragma unroll
      for (int s2 = 0; s2 < 8; ++s2) { const float v = segt[s2 * 32 + a]; tot += v; if (s2 < seg) off += v; }
      if (seg == 0) EBL[tk * 32 + a] = __expf(tot);
#pragma unroll
      for (int j = 0; j < 8; ++j) Kh[(seg * 8 + j) * 33 + a] = kv[j] * __expf(tot - (c8[j] + off));
      __syncthreads();
      const int vcol = wave * 16 + c16;
      float vb[16];
#pragma unroll
      for (int ks = 0; ks < 16; ++ks) vb[ks] = Z[(size_t)(T0 + rmap(dir, ks * 4 + q)) * PW + 1024 + head * 64 + vcol];
      f32x4 D[2];
#pragma unroll
      for (int ta = 0; ta < 2; ++ta)
#pragma unroll
        for (int e = 0; e < 4; ++e) D[ta][e] = 0.f;
#pragma unroll
      for (int ks = 0; ks < 16; ++ks) {
        const int ii = ks * 4 + q;
#pragma unroll
        for (int ta = 0; ta < 2; ++ta) D[ta] = __builtin_amdgcn_mfma_f32_16x16x4f32(Kh[ii * 33 + ta * 16 + c16], vb[ks], D[ta], 0, 0, 0);
      }
#pragma unroll
      for (int ta = 0; ta < 2; ++ta)
#pragma unroll
        for (int e = 0; e < 4; ++e) DG[(size_t)tk * 2048 + (ta * 16 + 4 * q + e) * 64 + vcol] = D[ta][e];
    }
  }
}

__device__ __forceinline__ bf16x8 split_hi(const f32x4& x0, const f32x4& x1, f32x4& r0, f32x4& r1) {
  union { bf16x8 v; unsigned u[4]; } o;
  unsigned hh[8];
#pragma unroll
  for (int e = 0; e < 4; ++e) { hh[e] = f2bf(x0[e]); hh[4 + e] = f2bf(x1[e]); r0[e] = x0[e] - __uint_as_float(hh[e] << 16); r1[e] = x1[e] - __uint_as_float(hh[4 + e] << 16); }
#pragma unroll
  for (int j = 0; j < 4; ++j) o.u[j] = hh[2 * j] | (hh[2 * j + 1] << 16);
  return o.v;
}
__device__ __forceinline__ bf16x8 pack_bf(const f32x4& x0, const f32x4& x1) {
  union { bf16x8 v; unsigned u[4]; } o;
  o.u[0] = pk2(x0[0], x0[1]); o.u[1] = pk2(x0[2], x0[3]); o.u[2] = pk2(x1[0], x1[1]); o.u[3] = pk2(x1[2], x1[3]);
  return o.v;
}
__device__ __forceinline__ void delta_scan_item(const Params& p, int l, int seq, int head, int dir, char* smem) {
  const int tid = ltid(), lane = tid & 63, wave = tid >> 6, c16 = lane & 15, q = lane >> 4;
  const bool lat = seq >= 16;
  const int b = lat ? seq - 16 : seq;
  const int T0s = lat ? 4096 + b * 1024 : b * 256;
  const int nch = lat ? 16 : 4;
  float* UW = (float*)(p.ws + OFF_UW);
  float* SDC = (float*)(p.ws + OFF_SDC);
  const float* EGL = (const float*)(p.ws + OFF_EGL);
  const int vcol = wave * 16 + c16;
  f32x4 S[4];
  if (lat) {
    const float* s0 = p.in[I_SD] + (size_t)(((b * 4 + l) * 2 + dir) * 4 + head) * 4096;
#pragma unroll
    for (int tr = 0; tr < 4; ++tr)
#pragma unroll
      for (int e = 0; e < 4; ++e) S[tr][e] = s0[(tr * 16 + 4 * q + e) * 64 + vcol];
  } else {
#pragma unroll
    for (int tr = 0; tr < 4; ++tr)
#pragma unroll
      for (int e = 0; e < 4; ++e) S[tr][e] = 0.f;
  }
  const int soff = (lane >> 3) * 128 + (((lane & 7) ^ (lane >> 3)) * 16);
#define DSTAGE(buf, tixv) do { const char* gsrc = (const char*)(UW + (size_t)(tixv) * 12288 + 4096); _Pragma("unroll") for (int i = 0; i < 8; ++i) { \
      __builtin_amdgcn_global_load_lds((const unsigned*)(gsrc + (wave * 8 + i) * 1024 + soff), (LAS unsigned*)(smem + (buf) * 32768 + (wave * 8 + i) * 1024), 16, 0, 0); } } while (0)
  const int foff = c16 * 128 + 8 * (q & 1);
  const int fch = (q >> 1);
  const int fsw = c16 & 7;
#define FRAG(img, tile, s2) ({ union { bf16x8 v; uint2 u[2]; } f_; const char* b_ = (img) + (tile) * 2048 + foff; \
      f_.u[0] = *(const uint2*)(b_ + (((4 * (s2) + fch) ^ fsw) * 16)); f_.u[1] = *(const uint2*)(b_ + (((4 * (s2) + 2 + fch) ^ fsw) * 16)); f_.v; })
  __syncthreads();
  {
    const int cc0 = dir ? nch - 1 : 0;
    DSTAGE(0, (((T0s >> 6) + cc0) * 4 + head) * 2 + dir);
  }
  f32x4 Uv[4]; float egl;
  {
    const int cc0 = dir ? nch - 1 : 0;
    const size_t tix0 = (size_t)((((T0s >> 6) + cc0) * 4 + head) * 2 + dir);
#pragma unroll
    for (int tr = 0; tr < 4; ++tr)
#pragma unroll
      for (int e = 0; e < 4; ++e) Uv[tr][e] = UW[tix0 * 12288 + (tr * 16 + 4 * q + e) * 64 + vcol];
    egl = EGL[tix0];
  }
  asm volatile("s_waitcnt vmcnt(0)" ::: "memory");
  __syncthreads();
  f32x4 Sp[4], T[4]; size_t tixp = 0;
  for (int cs = 0; cs < nch; ++cs) {
    const int cc = dir ? nch - 1 - cs : cs;
    const int cgk = (T0s >> 6) + cc;
    const size_t tix = (size_t)((cgk * 4 + head) * 2 + dir);
    const int ccn = (cs + 1 < nch) ? (dir ? nch - 2 - cs : cs + 1) : cc;
    const size_t tixn = (size_t)((((T0s >> 6) + ccn) * 4 + head) * 2 + dir);
    f32x4 Un[4];
#pragma unroll
    for (int tr = 0; tr < 4; ++tr)
#pragma unroll
      for (int e = 0; e < 4; ++e) Un[tr][e] = UW[tixn * 12288 + (tr * 16 + 4 * q + e) * 64 + vcol];
    const float egln = EGL[tixn];
    asm volatile("" ::: "memory");
    if (cs + 1 < nch) DSTAGE((cs + 1) & 1, tixn);
    asm volatile("" ::: "memory");
    if (cs > 0) {
#pragma unroll
      for (int tr = 0; tr < 4; ++tr)
#pragma unroll
        for (int e = 0; e < 4; ++e) {
          SDC[tixp * 4096 + (tr * 16 + 4 * q + e) * 64 + vcol] = Sp[tr][e];
          UW[tixp * 12288 + (tr * 16 + 4 * q + e) * 64 + vcol] = T[tr][e];
        }
    }
    asm volatile("" ::: "memory");
    const char* Whi = smem + (cs & 1) * 32768;
    const char* Wlo = Whi + 8192;
    const char* Khi = Whi + 16384;
    const char* Klo = Whi + 24576;
#pragma unroll
    for (int tr = 0; tr < 4; ++tr) Sp[tr] = S[tr];
    {
      bf16x8 bh[2], bl[2];
#pragma unroll
      for (int s2 = 0; s2 < 2; ++s2) { f32x4 r0, r1; bh[s2] = split_hi(S[2 * s2], S[2 * s2 + 1], r0, r1); bl[s2] = pack_bf(r0, r1); }
#pragma unroll
      for (int tr = 0; tr < 4; ++tr) {
        f32x4 acc = {0.f, 0.f, 0.f, 0.f};
#pragma unroll
        for (int s2 = 0; s2 < 2; ++s2) {
          const bf16x8 ah = FRAG(Whi, tr, s2);
          const bf16x8 al = FRAG(Wlo, tr, s2);
          acc = __builtin_amdgcn_mfma_f32_16x16x32_bf16(ah, bh[s2], acc, 0, 0, 0);
          acc = __builtin_amdgcn_mfma_f32_16x16x32_bf16(ah, bl[s2], acc, 0, 0, 0);
          acc = __builtin_amdgcn_mfma_f32_16x16x32_bf16(al, bh[s2], acc, 0, 0, 0);
        }
#pragma unroll
        for (int e = 0; e < 4; ++e) T[tr][e] = Uv[tr][e] - acc[e];
      }
    }
    {
      bf16x8 bh[2], bl[2];
#pragma unroll
      for (int s2 = 0; s2 < 2; ++s2) { f32x4 r0, r1; bh[s2] = split_hi(T[2 * s2], T[2 * s2 + 1], r0, r1); bl[s2] = pack_bf(r0, r1); }
#pragma unroll
      for (int ta = 0; ta < 4; ++ta) {
        f32x4 acc;
#pragma unroll
        for (int e = 0; e < 4; ++e) acc[e] = S[ta][e] * egl;
#pragma unroll
        for (int s2 = 0; s2 < 2; ++s2) {
          const bf16x8 ah = FRAG(Khi, ta, s2);
          const bf16x8 al = FRAG(Klo, ta, s2);
          acc = __builtin_amdgcn_mfma_f32_16x16x32_bf16(ah, bh[s2], acc, 0, 0, 0);
          acc = __builtin_amdgcn_mfma_f32_16x16x32_bf16(ah, bl[s2], acc, 0, 0, 0);
          acc = __builtin_amdgcn_mfma_f32_16x16x32_bf16(al, bh[s2], acc, 0, 0, 0);
        }
        S[ta] = acc;
      }
    }
    tixp = tix;
    asm volatile("s_waitcnt vmcnt(0)" ::: "memory");
#pragma unroll
    for (int tr = 0; tr < 4; ++tr) Uv[tr] = Un[tr];
    egl = egln;
    __syncthreads();
  }
#pragma unroll
  for (int tr = 0; tr < 4; ++tr)
#pragma unroll
    for (int e = 0; e < 4; ++e) {
      SDC[tixp * 4096 + (tr * 16 + 4 * q + e) * 64 + vcol] = Sp[tr][e];
      UW[tixp * 12288 + (tr * 16 + 4 * q + e) * 64 + vcol] = T[tr][e];
    }
#undef DSTAGE
#undef FRAG
  if (!lat) {
    float* o = p.out + O_NSD + (size_t)(((b * 4 + l) * 2 + dir) * 4 + head) * 4096;
#pragma unroll
    for (int tr = 0; tr < 4; ++tr)
#pragma unroll
      for (int e = 0; e < 4; ++e) o[(tr * 16 + 4 * q + e) * 64 + vcol] = S[tr][e];
  }
}

__device__ __forceinline__ void gla_scan_item(const Params& p, int l, int seq, int head, int dir, char* smem) {
  const int tid = ltid();
  const bool lat = seq >= 16;
  const int b = lat ? seq - 16 : seq;
  const int T0s = lat ? 4096 + b * 1024 : b * 256;
  const int nch = lat ? 16 : 4;
  const float* DG = (const float*)(p.ws + OFF_DG);
  const float* EBL = (const float*)(p.ws + OFF_EBL);
  float* SGC = (float*)(p.ws + OFF_SGC);
  const int e0 = tid * 8, krow = tid >> 3;
  float S[8];
  if (lat) {
    const float* s0 = p.in[I_SG] + (size_t)(((b * 4 + l) * 2 + dir) * 4 + head) * 2048 + e0;
    const float4 a4 = *(const float4*)s0, b4 = *(const float4*)(s0 + 4);
    S[0] = a4.x; S[1] = a4.y; S[2] = a4.z; S[3] = a4.w; S[4] = b4.x; S[5] = b4.y; S[6] = b4.z; S[7] = b4.w;
  } else {
#pragma unroll
    for (int i = 0; i < 8; ++i) S[i] = 0.f;
  }
  for (int cs0 = 0; cs0 < nch; cs0 += 4) {
    float4 d0[4], d1[4]; float eb[4];
#pragma unroll
    for (int u = 0; u < 4; ++u) {
      const int cs = cs0 + u;
      const int cc = dir ? nch - 1 - cs : cs;
      const size_t tix = (size_t)((((T0s >> 6) + cc) * 4 + head) * 2 + dir);
      d0[u] = *(const float4*)(DG + tix * 2048 + e0); d1[u] = *(const float4*)(DG + tix * 2048 + e0 + 4);
      eb[u] = EBL[tix * 32 + krow];
    }
#pragma unroll
    for (int u = 0; u < 4; ++u) {
      const int cs = cs0 + u;
      const int cc = dir ? nch - 1 - cs : cs;
      const size_t tix = (size_t)((((T0s >> 6) + cc) * 4 + head) * 2 + dir);
      float4 o0, o1; o0.x = S[0]; o0.y = S[1]; o0.z = S[2]; o0.w = S[3]; o1.x = S[4]; o1.y = S[5]; o1.z = S[6]; o1.w = S[7];
      *(float4*)(SGC + tix * 2048 + e0) = o0; *(float4*)(SGC + tix * 2048 + e0 + 4) = o1;
      S[0] = eb[u] * S[0] + d0[u].x; S[1] = eb[u] * S[1] + d0[u].y; S[2] = eb[u] * S[2] + d0[u].z; S[3] = eb[u] * S[3] + d0[u].w;
      S[4] = eb[u] * S[4] + d1[u].x; S[5] = eb[u] * S[5] + d1[u].y; S[6] = eb[u] * S[6] + d1[u].z; S[7] = eb[u] * S[7] + d1[u].w;
    }
  }
  if (!lat) {
    float* o = p.out + O_NSG + (size_t)(((b * 4 + l) * 2 + dir) * 4 + head) * 2048 + e0;
    float4 o0, o1; o0.x = S[0]; o0.y = S[1]; o0.z = S[2]; o0.w = S[3]; o1.x = S[4]; o1.y = S[5]; o1.z = S[6]; o1.w = S[7];
    *(float4*)o = o0; *(float4*)(o + 4) = o1;
  }
}

__device__ __forceinline__ void attn_item(const Params& p, int l, bool lat, int idx, char* smem) {
  char* sK = smem;
  u16* sVt = (u16*)(smem + 16384);
  const int tid = ltid(), lane = tid & 63, wave = tid >> 6, r = lane & 31, h = lane >> 5;
  int b, g, qt, T0, nkeys;
  if (lat) { b = idx >> 6; g = (idx >> 5) & 1; qt = idx & 31; T0 = 4096 + b * 1024; nkeys = 1536; }
  else { b = idx >> 4; g = (idx >> 3) & 1; qt = idx & 7; T0 = b * 256; nkeys = 256; }
  const int q0 = T0 + qt * 32;
  const int hq = g * 4 + wave;
  const u16* QB = (const u16*)(p.ws + OFF_QB); const u16* KB = (const u16*)(p.ws + OFF_KB); const u16* VB = (const u16*)(p.ws + OFF_VB);
  const u16* CKB = (const u16*)(p.ws + OFF_CKB) + (size_t)b * 65536; const u16* CVB = (const u16*)(p.ws + OFF_CVB) + (size_t)b * 65536;
  u16* MIXIN = (u16*)(p.ws + OFF_MIXIN);
  bf16x8 qf[4];
#pragma unroll
  for (int s = 0; s < 4; ++s) qf[s] = *(const bf16x8*)(QB + (size_t)(q0 + r) * 512 + hq * 64 + 16 * s + 8 * h);
  f32x16 accO[2];
#pragma unroll
  for (int i = 0; i < 2; ++i)
#pragma unroll
    for (int e = 0; e < 16; ++e) accO[i][e] = 0.f;
  float m_run = -INFINITY, l_run = 0.f;
  const float scale2 = 0.125f * 1.4426950408889634f;
  const int skey = tid >> 2, dq = (tid & 3) * 16;
  const int krow = (lane >> 3), kpos = lane & 7;
  const int fsw = (r >> 1) & 7;
#define KV_ROWS(key0, kp, vp) do { if (lat && (key0) < 512) { kp = CKB + (size_t)(key0) * 128 + g * 64; vp = CVB + (size_t)(key0) * 128 + g * 64; } \
      else { const int t0_ = T0 + (lat ? (key0) - 512 : (key0)); kp = KB + (size_t)t0_ * 128 + g * 64; vp = VB + (size_t)t0_ * 128 + g * 64; } } while (0)
#define K_STAGE(buf, kp) do { _Pragma("unroll") for (int i = 0; i < 2; ++i) { const int row = (wave * 2 + i) * 8 + krow; \
      __builtin_amdgcn_global_load_lds((const unsigned*)((kp) + (size_t)row * 128 + ((kpos ^ ((row >> 1) & 7)) * 8)), \
                                       (LAS unsigned*)(sK + (buf) * 8192 + (wave * 2 + i) * 1024), 16, 0, 0); } } while (0)
  uint4 v0, v1;
  __syncthreads();
  {
    const u16* kp; const u16* vp; KV_ROWS(0, kp, vp);
    K_STAGE(0, kp);
    v0 = *(const uint4*)(vp + (size_t)skey * 128 + dq); v1 = *(const uint4*)(vp + (size_t)skey * 128 + dq + 8);
  }
  const int ntile = nkeys >> 6;
  for (int kt = 0; kt < ntile; ++kt) {
    {
      u16* dst = sVt + (kt & 1) * 64 * 72;
      const unsigned vw[8] = {v0.x, v0.y, v0.z, v0.w, v1.x, v1.y, v1.z, v1.w};
#pragma unroll
      for (int i = 0; i < 8; ++i) {
        dst[(dq + 2 * i) * 72 + skey] = (u16)(vw[i] & 0xffffu);
        dst[(dq + 2 * i + 1) * 72 + skey] = (u16)(vw[i] >> 16);
      }
    }
    asm volatile("s_waitcnt vmcnt(0)" ::: "memory");
    __syncthreads();
    if (kt + 1 < ntile) {
      const u16* kp; const u16* vp; KV_ROWS((kt + 1) * 64, kp, vp);
      K_STAGE((kt + 1) & 1, kp);
      v0 = *(const uint4*)(vp + (size_t)skey * 128 + dq); v1 = *(const uint4*)(vp + (size_t)skey * 128 + dq + 8);
    }
    const char* cK = sK + (kt & 1) * 8192;
    const u16* cV = sVt + (kt & 1) * 64 * 72;
    f32x16 accS[2];
#pragma unroll
    for (int mt = 0; mt < 2; ++mt) {
#pragma unroll
      for (int e = 0; e < 16; ++e) accS[mt][e] = 0.f;
#pragma unroll
      for (int s = 0; s < 4; ++s) {
        bf16x8 kfr = *(const bf16x8*)(cK + (mt * 32 + r) * 128 + (((2 * s + h) ^ fsw) * 16));
        accS[mt] = __builtin_amdgcn_mfma_f32_32x32x16_bf16(kfr, qf[s], accS[mt], 0, 0, 0);
      }
    }
    float mx = accS[0][0];
#pragma unroll
    for (int mt = 0; mt < 2; ++mt)
#pragma unroll
      for (int e = 0; e < 16; ++e) mx = fmaxf(mx, accS[mt][e]);
    mx = fmaxf(mx, __shfl_xor(mx, 32));
    const float m_new = fmaxf(m_run, mx * scale2);
    const float alpha = __builtin_amdgcn_exp2f(m_run - m_new);
    m_run = m_new;
    float ls = 0.f;
#pragma unroll
    for (int mt = 0; mt < 2; ++mt)
#pragma unroll
      for (int e = 0; e < 16; ++e) { const float pv = __builtin_amdgcn_exp2f(accS[mt][e] * scale2 - m_new); accS[mt][e] = pv; ls += pv; }
    l_run = l_run * alpha + ls;
#pragma unroll
    for (int i = 0; i < 2; ++i)
#pragma unroll
      for (int e = 0; e < 16; ++e) accO[i][e] *= alpha;
#pragma unroll
    for (int ks = 0; ks < 4; ++ks) {
      const int mt = ks >> 1, base = 8 * (ks & 1);
      union { bf16x8 v; unsigned u[4]; } pf;
#pragma unroll
      for (int j = 0; j < 4; ++j) pf.u[j] = pk2(accS[mt][base + 2 * j], accS[mt][base + 2 * j + 1]);
#pragma unroll
      for (int dt = 0; dt < 2; ++dt) {
        union { bf16x8 v; uint2 u[2]; } vf;
        vf.u[0] = *(const uint2*)(cV + (dt * 32 + r) * 72 + 16 * ks + 4 * h);
        vf.u[1] = *(const uint2*)(cV + (dt * 32 + r) * 72 + 16 * ks + 8 + 4 * h);
        accO[dt] = __builtin_amdgcn_mfma_f32_32x32x16_bf16(vf.v, pf.v, accO[dt], 0, 0, 0);
      }
    }
  }
#undef KV_ROWS
#undef K_STAGE
  const float ltot = l_run + __shfl_xor(l_run, 32);
  const float inv = 1.f / ltot;
#pragma unroll
  for (int dt = 0; dt < 2; ++dt)
#pragma unroll
    for (int rg = 0; rg < 4; ++rg) {
      const int d = dt * 32 + 8 * rg + 4 * h;
      uint2 o;
      o.x = pk2(accO[dt][rg * 4 + 0] * inv, accO[dt][rg * 4 + 1] * inv);
      o.y = pk2(accO[dt][rg * 4 + 2] * inv, accO[dt][rg * 4 + 3] * inv);
      *(uint2*)(MIXIN + (size_t)(q0 + r) * 1024 + hq * 64 + d) = o;
    }
}

__device__ __forceinline__ void phase_scan_attn(const Params& p, int l, char* smem) {
  for (int it = lbid(); it < 832; it += gridDim.x) {
    int type, j; bool lat;
    if (it < 32) { type = 0; j = it; lat = true; }
    else if (it < 64) { type = 1; j = it - 32; lat = true; }
    else if (it < 320) { type = 2; j = it - 64; lat = true; }
    else if (it < 448) { type = 0; j = it - 320; lat = false; }
    else if (it < 576) { type = 1; j = it - 448; lat = false; }
    else { type = 2; j = it - 576; lat = false; }
    const int seq = (lat ? 16 : 0) + (j >> 3), head = (j >> 1) & 3, dir = j & 1;
    if (type == 0) delta_scan_item(p, l, seq, head, dir, smem);
    else if (type == 1) gla_scan_item(p, l, seq, head, dir, smem);
    else attn_item(p, l, lat, j, smem);
  }
  if (l < 3 && (int)gridDim.x > 384 && lbid() >= 320) phase_wconv(p, smem, l + 1, 320, gridDim.x - 320);
  else if (l < 3 && (int)gridDim.x <= 384) phase_wconv(p, smem, l + 1, 0, gridDim.x);
}

__device__ __forceinline__ void phase_out(const Params& p, int l, char* smem) {
  const int tid = ltid(), lane = tid & 63, wave = tid >> 6, r = lane & 31, h = lane >> 5;
  const float* Z = (const float*)(p.ws + OFF_Z);
  const float* CB = (const float*)(p.ws + OFF_CB);
  const float* GDEC = (const float*)(p.ws + OFF_GDEC);
  const float* GLOG = (const float*)(p.ws + OFF_GLOG);
  const float* UW = (const float*)(p.ws + OFF_UW);
  const float* SDC = (const float*)(p.ws + OFF_SDC);
  const float* SGC = (const float*)(p.ws + OFF_SGC);
  u16* MIXIN = (u16*)(p.ws + OFF_MIXIN);
  const int ti = wave >> 1, tj = wave & 1;
  for (int task = lbid(); task < 1024; task += gridDim.x) {
    const bool isgla = task >= 512;
    const int tk = task & 511;
    const int cgk = tk >> 2, head = tk & 3;
    const int T0 = cgk * 64;
    float* Ob = (float*)smem;
    float* Att = Ob + 64 * 65;
    float* Qs = Att + 64 * 65;
    float* Ks = Qs + 64 * 65;
    float* gam = Ks + 64 * 65;
    __syncthreads();
#pragma unroll
    for (int i = 0; i < 16; ++i) { const int e = tid + i * 256; Ob[(e >> 6) * 65 + (e & 63)] = 0.f; }
    if (!isgla) {
#pragma unroll
      for (int i = 0; i < 4; ++i) {
        const int e4 = tid + i * 256, row = e4 >> 4, d4 = (e4 & 15) * 4;
        const float4 q4 = *(const float4*)(CB + (size_t)(T0 + row) * 768 + head * 64 + d4);
        Qs[row * 65 + d4] = q4.x; Qs[row * 65 + d4 + 1] = q4.y; Qs[row * 65 + d4 + 2] = q4.z; Qs[row * 65 + d4 + 3] = q4.w;
      }
    }
    for (int dir = 0; dir < 2; ++dir) {
      const size_t tix = (size_t)((cgk * 4 + head) * 2 + dir);
      int rL = r, hL = h; asm volatile("" : "+v"(rL), "+v"(hL));
      __syncthreads();
      if (!isgla) {
#pragma unroll 2
        for (int i = 0; i < 4; ++i) {
          const int e4 = tid + i * 256, row = e4 >> 4, d4 = (e4 & 15) * 4;
          const float4 k4 = *(const float4*)(CB + (size_t)(T0 + row) * 768 + 256 + head * 64 + d4);
          Ks[row * 65 + d4] = k4.x; Ks[row * 65 + d4 + 1] = k4.y; Ks[row * 65 + d4 + 2] = k4.z; Ks[row * 65 + d4 + 3] = k4.w;
        }
        if (wave == 0) {
          float g = GDEC[(T0 + rmap(dir, lane)) * 8 + dir * 4 + head];
          g = wave_cumsum(g, lane);
          gam[lane] = g;
        }
        __syncthreads();
        {
          f32x16 acc;
#pragma unroll
          for (int e = 0; e < 16; ++e) acc[e] = 0.f;
          if (tj <= ti) {
            const float* ap = Qs + rmap(dir, ti * 32 + r) * 65 + h;
            const float* bp = Ks + rmap(dir, tj * 32 + r) * 65 + h;
#pragma unroll 8
            for (int k2 = 0; k2 < 32; ++k2) acc = __builtin_amdgcn_mfma_f32_32x32x2f32(ap[2 * k2], bp[2 * k2], acc, 0, 0, 0);
          }
          const int sidx = tj * 32 + rL;
          const float gs = gam[sidx];
#pragma unroll
          for (int e = 0; e < 16; ++e) {
            const int tt = ti * 32 + (e & 3) + 8 * (e >> 2) + 4 * hL;
            Att[tt * 65 + sidx] = (sidx <= tt) ? acc[e] * __expf(gam[tt] - gs) : 0.f;
          }
        }
        __syncthreads();
        {
          f32x16 a1, a2;
#pragma unroll
          for (int e = 0; e < 16; ++e) { a1[e] = 0.f; a2[e] = 0.f; }
          float* Sl = Ks;
#pragma unroll
          for (int i = 0; i < 4; ++i) {
            const int e4 = tid + i * 256;
            *(float4*)(Sl + e4 * 4) = *(const float4*)(SDC + tix * 4096 + e4 * 4);
          }
          const float* vp = UW + tix * 12288 + h * 64 + tj * 32 + r;
          float vb[16];
#pragma unroll
          for (int k2 = 0; k2 < 16; ++k2) vb[k2] = vp[2 * k2 * 64];
          __syncthreads();
          const float* ap = Qs + rmap(dir, ti * 32 + r) * 65 + h;
          const float* sp = Sl + h * 64 + tj * 32 + r;
          const float* ap2 = Att + (ti * 32 + r) * 65 + h;
#pragma unroll
          for (int k2 = 0; k2 < 16; ++k2) {
            a1 = __builtin_amdgcn_mfma_f32_32x32x2f32(ap[2 * k2], sp[2 * k2 * 64], a1, 0, 0, 0);
            a2 = __builtin_amdgcn_mfma_f32_32x32x2f32(ap2[2 * k2], vb[k2], a2, 0, 0, 0);
          }
#pragma unroll
          for (int k2 = 0; k2 < 16; ++k2) vb[k2] = vp[2 * (k2 + 16) * 64];
#pragma unroll
          for (int k2 = 16; k2 < 32; ++k2) {
            a1 = __builtin_amdgcn_mfma_f32_32x32x2f32(ap[2 * k2], sp[2 * k2 * 64], a1, 0, 0, 0);
            a2 = __builtin_amdgcn_mfma_f32_32x32x2f32(ap2[2 * k2], vb[k2 - 16], a2, 0, 0, 0);
          }
#pragma unroll
          for (int e = 0; e < 16; ++e) {
            const int tt = ti * 32 + (e & 3) + 8 * (e >> 2) + 4 * hL;
            Ob[rmap(dir, tt) * 65 + tj * 32 + r] += a1[e] * __expf(gam[tt]) + a2[e];
          }
        }
      } else {
        float* segt = gam;
        const int a = tid & 31, seg = tid >> 5;
        float c8[8]; float run = 0.f;
#pragma unroll
        for (int j = 0; j < 8; ++j) {
          run += GLOG[(size_t)(T0 + rmap(dir, seg * 8 + j)) * 256 + dir * 128 + head * 32 + a];
          c8[j] = run;
        }
        segt[seg * 32 + a] = run;
        __syncthreads();
        float off = 0.f;
#pragma unroll
        for (int s2 = 0; s2 < 8; ++s2) { const float v = segt[s2 * 32 + a]; if (s2 < seg) off += v; }
#pragma unroll
        for (int j = 0; j < 8; ++j) {
          const int i = seg * 8 + j;
          const float bb = c8[j] + off;
          const float* zr = Z + (size_t)(T0 + rmap(dir, i)) * PW;
          Qs[i * 33 + a] = zr[768 + head * 32 + a] * 0.17677669529663687f * __expf(bb);
          Ks[i * 33 + a] = zr[896 + head * 32 + a] * __expf(-bb);
        }
        __syncthreads();
        {
          f32x16 acc;
#pragma unroll
          for (int e = 0; e < 16; ++e) acc[e] = 0.f;
          if (tj <= ti) {
            const float* ap = Qs + (ti * 32 + r) * 33 + h;
            const float* bp = Ks + (tj * 32 + r) * 33 + h;
#pragma unroll 8
            for (int k2 = 0; k2 < 16; ++k2) acc = __builtin_amdgcn_mfma_f32_32x32x2f32(ap[2 * k2], bp[2 * k2], acc, 0, 0, 0);
          }
          const int sidx = tj * 32 + rL;
#pragma unroll
          for (int e = 0; e < 16; ++e) {
            const int tt = ti * 32 + (e & 3) + 8 * (e >> 2) + 4 * hL;
            Att[tt * 65 + sidx] = (sidx <= tt) ? acc[e] : 0.f;
          }
        }
        __syncthreads();
        {
          f32x16 a1;
#pragma unroll
          for (int e = 0; e < 16; ++e) a1[e] = 0.f;
          const float* ap = Qs + (ti * 32 + r) * 33 + h;
          const float* sp = SGC + tix * 2048 + h * 64 + tj * 32 + r;
          float sb[16], vb[16];
#pragma unroll
          for (int k2 = 0; k2 < 16; ++k2) sb[k2] = sp[2 * k2 * 64];
#pragma unroll
          for (int k2 = 0; k2 < 16; ++k2) vb[k2] = Z[(size_t)(T0 + rmap(dir, 2 * k2 + h)) * PW + 1024 + head * 64 + tj * 32 + r];
#pragma unroll
          for (int k2 = 0; k2 < 16; ++k2) a1 = __builtin_amdgcn_mfma_f32_32x32x2f32(ap[2 * k2], sb[k2], a1, 0, 0, 0);
          const float* ap2 = Att + (ti * 32 + r) * 65 + h;
#pragma unroll
          for (int k2 = 0; k2 < 16; ++k2) a1 = __builtin_amdgcn_mfma_f32_32x32x2f32(ap2[2 * k2], vb[k2], a1, 0, 0, 0);
#pragma unroll
          for (int k2 = 0; k2 < 16; ++k2) vb[k2] = Z[(size_t)(T0 + rmap(dir, 2 * (k2 + 16) + h)) * PW + 1024 + head * 64 + tj * 32 + r];
#pragma unroll
          for (int k2 = 16; k2 < 32; ++k2) a1 = __builtin_amdgcn_mfma_f32_32x32x2f32(ap2[2 * k2], vb[k2 - 16], a1, 0, 0, 0);
#pragma unroll
          for (int e = 0; e < 16; ++e) {
            const int tt = ti * 32 + (e & 3) + 8 * (e >> 2) + 4 * hL;
            Ob[rmap(dir, tt) * 65 + tj * 32 + r] += a1[e];
          }
        }
      }
    }
    __syncthreads();
    {
      const int row = tid >> 2, part = tid & 3;
      float v[16]; float ss = 0.f;
#pragma unroll
      for (int i = 0; i < 16; ++i) { v[i] = Ob[row * 65 + part * 16 + i]; ss += v[i] * v[i]; }
      ss += __shfl_xor(ss, 1); ss += __shfl_xor(ss, 2);
      const float rstd = rsqrtf(ss * (1.f / 64.f) + EPSF);
      const float* gn = isgla ? (p.in[I_GLAN] + l * 64) : (p.in[I_DELN] + l * 64);
      const float* gz = Z + (size_t)(T0 + row) * PW + (isgla ? 1280 : 2336) + head * 64 + part * 16;
      u16* mo = MIXIN + (size_t)(T0 + row) * 1024 + (isgla ? 512 : 768) + head * 64 + part * 16;
      unsigned o[8];
#pragma unroll
      for (int i = 0; i < 8; ++i) {
        const float y0 = v[2 * i] * rstd * gn[part * 16 + 2 * i] * siluf(gz[2 * i]);
        const float y1 = v[2 * i + 1] * rstd * gn[part * 16 + 2 * i + 1] * siluf(gz[2 * i + 1]);
        o[i] = pk2(y0, y1);
      }
      uint4 o0, o1; o0.x = o[0]; o0.y = o[1]; o0.z = o[2]; o0.w = o[3]; o1.x = o[4]; o1.y = o[5]; o1.z = o[6]; o1.w = o[7];
      *(uint4*)mo = o0; *(uint4*)(mo + 8) = o1;
    }
  }
}

__device__ __forceinline__ void run_phase(const Params& p, int ph, char* smem) {
  if (ph == 0) { phase_mod(p, smem); phase_wconv(p, smem, 0, 0, gridDim.x); return; }
  const int l = (ph - 1) / 10, s = (ph - 1) % 10;
  const u16* H = (const u16*)(p.ws + OFF_H);
  const u16* WT = (const u16*)(p.ws + OFF_WT) + (size_t)l * WT_LAYER;
  if (s == 1) { phase_gemm<0>(H, 1024, WT + WT_IN, nullptr, PW, p.ws + OFF_Z, smem); return; }
  if (s == 6 || s == 9) {
    const u16* A; int K; const u16* W;
    if (s == 6) { A = (const u16*)(p.ws + OFF_MIXIN); K = 1024; W = WT + WT_OUT; }
    else { A = (const u16*)(p.ws + OFF_Z); K = DFF; W = WT + WT_DOWN; }
    phase_gemm<2>(A, K, W, nullptr, 1024, p.ws + OFF_MIX, smem);
    return;
  }
  if (s == 0 || s == 7) { phase_row(p, l, s == 0 ? 0 : 1); return; }
  switch (s) {
    case 2: phase_prep(p, l); break;
    case 3: phase_local(p, l, smem); break;
    case 4: phase_scan_attn(p, l, smem); break;
    case 5: phase_out(p, l, smem); break;
    case 8: phase_gemm<1>(H, 1024, WT + WT_GATE, WT + WT_UP, DFF, p.ws + OFF_Z, smem); break;
  }
}


#define XB_TMO      128
#define XB_XCNT(j)  (256  + 64 * (j))
#define XB_XSUB(j)  (1280 + 64 * (j))
#define XB_XGEN(j)  (2304 + 64 * (j))
#define XB_TOP      3328
#define XB_TOPGEN   3392
#define XCD_BAR_WORDS 3456
#define XB_SPIN_CAP (1u << 22)
__device__ __forceinline__ unsigned xb_ld(unsigned* p)              { return __hip_atomic_load(p, __ATOMIC_RELAXED, __HIP_MEMORY_SCOPE_AGENT); }
__device__ __forceinline__ unsigned xb_add(unsigned* p, unsigned v) { return __hip_atomic_fetch_add(p, v, __ATOMIC_RELAXED, __HIP_MEMORY_SCOPE_AGENT); }
__device__ __forceinline__ unsigned xb_xcc_id() { return (unsigned)__builtin_amdgcn_s_getreg((3 << 11) | 20) & 0xFu; }
#define XB_SPIN(cond, bar) do { unsigned _sp = 0; while (cond) { __builtin_amdgcn_s_sleep(1); \
    if ((++_sp & 255u) == 0u) { if (xb_ld(&(bar)[XB_TMO])) break; if (_sp > XB_SPIN_CAP) { atomicAdd(&(bar)[XB_TMO], 1u); break; } } } } while (0)
struct XcdBarrier { unsigned* bar; unsigned x; volatile LAS unsigned* st; };
__device__ __forceinline__ XcdBarrier xcd_barrier_post(unsigned* bar, volatile LAS unsigned* st) {
    XcdBarrier b; b.bar = bar; b.x = xb_xcc_id(); b.st = st;
    if (threadIdx.x == 0) (void)xb_add(&bar[XB_XCNT(b.x)], 1u);
    return b;
}
__device__ __forceinline__ void xcd_barrier_complete(unsigned* bar, unsigned x, unsigned& nloc, unsigned& nx) {
    const unsigned G = gridDim.x * gridDim.y * gridDim.z;
    unsigned sum, cnt, mine, sp = 0u;
    for (;;) {
        sum = 0u; cnt = 0u; mine = 0u;
#pragma unroll
        for (unsigned j = 0; j < 16; ++j) { const unsigned c = xb_ld(&bar[XB_XCNT(j)]); sum += c; cnt += (c > 0u) ? 1u : 0u; mine = (j == x) ? c : mine; }
        if (sum == G) break;
        __builtin_amdgcn_s_sleep(1);
        if ((++sp & 255u) == 0u) { if (xb_ld(&bar[XB_TMO])) break; if (sp > XB_SPIN_CAP) { atomicAdd(&bar[XB_TMO], 1u); break; } }
    }
    nloc = mine > 0u ? mine : 1u; nx = cnt > 0u ? cnt : 1u;
}
__device__ __forceinline__ void xcd_barrier(const XcdBarrier& b) {
    asm volatile("s_waitcnt vmcnt(0)" ::: "memory");
    __syncthreads();
    if (threadIdx.x == 0) {
        unsigned* bar = b.bar;
        __builtin_amdgcn_s_waitcnt(0);
        unsigned nloc = b.st[0], nx = b.st[1];
        if (nloc == 0u) { xcd_barrier_complete(bar, b.x, nloc, nx); b.st[0] = nloc; b.st[1] = nx; }
        const unsigned old = xb_add(&bar[XB_XSUB(b.x)], 1u);
        const unsigned gen = old / nloc;
        if (old + 1u == (gen + 1u) * nloc) {
            __builtin_amdgcn_fence(__ATOMIC_RELEASE, "agent");
            asm volatile("s_waitcnt vmcnt(0)" ::: "memory");
            const unsigned og = xb_add(&bar[XB_TOP], 1u);
            const unsigned tg = og / nx;
            if (og + 1u == (tg + 1u) * nx) xb_add(&bar[XB_TOPGEN], 1u);
            else XB_SPIN(xb_ld(&bar[XB_TOPGEN]) == tg, bar);
            __builtin_amdgcn_fence(__ATOMIC_ACQUIRE, "agent");
            xb_add(&bar[XB_XGEN(b.x)], 1u);
            asm volatile("s_waitcnt vmcnt(0)" ::: "memory");
        } else {
            XB_SPIN(xb_ld(&bar[XB_XGEN(b.x)]) == gen, bar);
            __builtin_amdgcn_fence(__ATOMIC_ACQUIRE, "agent");
            asm volatile("s_waitcnt vmcnt(0)" ::: "memory");
        }
    }
    __syncthreads();
}

__global__ void __launch_bounds__(256, 2) mega(Params p, int ph_lo, int ph_hi) {
  extern __shared__ __attribute__((aligned(16))) char smem[];
  volatile LAS unsigned* st = (volatile LAS unsigned*)(smem + LDS_BYTES - 16);
  if (threadIdx.x == 0) { st[0] = 0u; st[1] = 0u; }
  __syncthreads();
  XcdBarrier xb = xcd_barrier_post((unsigned*)(p.ws + OFF_BAR), st);
  for (int ph = ph_lo; ph < ph_hi; ++ph) {
    if (ph > ph_lo) xcd_barrier(xb);
#ifdef PROBE_MASK
    const unsigned long long t0 = __builtin_amdgcn_s_memrealtime();
#endif
    run_phase(p, ph, smem);
#ifdef PROBE_MASK
    {
      const int sidx = (ph == 0) ? 10 : (ph - 1) % 10;
      if ((PROBE_MASK >> sidx) & 1) {
        xcd_barrier(xb);
        const unsigned long long t1 = __builtin_amdgcn_s_memrealtime();
        while (__builtin_amdgcn_s_memrealtime() - t1 < t1 - t0) __builtin_amdgcn_s_sleep(8);
      }
    }
#endif
  }
}

extern "C" void kernel_launch(void* const* d_in, const int* in_sizes, int n_in, void* d_out, int out_size, void* d_ws, size_t ws_size,
                              hipStream_t stream) {
  static int grid_blocks = 0;
  if (!grid_blocks) {
    int dev = 0, cus = 0, per_cu = 0;
    hipGetDevice(&dev);
    hipDeviceGetAttribute(&cus, hipDeviceAttributeMultiprocessorCount, dev);
    hipFuncSetAttribute((const void*)mega, hipFuncAttributeMaxDynamicSharedMemorySize, LDS_BYTES);
    hipOccupancyMaxActiveBlocksPerMultiprocessor(&per_cu, (const void*)mega, 256, LDS_BYTES);
    if (per_cu < 1) per_cu = 1;
    if (per_cu > 2) per_cu = 2;
    grid_blocks = cus * per_cu;
    if (ws_size < WS_END) fprintf(stderr, "kernel_launch: workspace too small (%zu < %zu)\n", ws_size, (size_t)WS_END);
  }
  hipMemsetAsync((char*)d_ws + OFF_BAR, 0, 16384, stream);
  Params p{};
  for (int i = 0; i < 24; ++i) p.in[i] = (const float*)d_in[i];
  p.out = (float*)d_out;
  p.ws = (char*)d_ws;
  int lo = 0, hi = 42;
  void* args[] = {&p, &lo, &hi};
  hipError_t e = hipLaunchCooperativeKernel((const void*)mega, dim3(grid_blocks), dim3(256), args, LDS_BYTES, stream);
  if (e != hipSuccess) fprintf(stderr, "cooperative launch failed: %s (grid %d)\n", hipGetErrorString(e), grid_blocks);
}
```
